# Optimizing an MI355X kernel written in HIP

```python
import jax, jax.numpy as jnp
from jax import lax
import numpy as np

D_MODEL = 1024
BATCH = 8
SEQ = 2048
DEPTH = 2

HEAD_DIM = 64
NSA_HEADS = 8
NSA_KV_GROUPS = 2
NSA_HPG = NSA_HEADS // NSA_KV_GROUPS
NSA_WIDTH = NSA_HEADS * HEAD_DIM
KV_WIDTH = NSA_KV_GROUPS * HEAD_DIM
CMP_BLOCK = 32
CMP_STRIDE = 16
CMP_HIDDEN = 128
SEL_BLOCK = 64
SEL_TOPK = 16
WINDOW = 512
Q_BLOCK = 128
GM_GROUPS = 8
GM_CHUNK = 128
GM_WIDTH = GM_GROUPS * HEAD_DIM
N_BRANCH = 2
D_FF = 2816
ROPE_THETA = 10000.0
EPS = 1e-6
NEG = -1e30
FORCE = 1e4
IN_SIZES = [NSA_WIDTH, 6 * KV_WIDTH, 3 * NSA_HEADS, 2 * GM_WIDTH, D_MODEL, D_MODEL]
IN_WIDTH = sum(IN_SIZES)
IN_SPLITS = np.cumsum(IN_SIZES)[:-1].tolist()

kernel_name = "hybrid_nsa_gmlp_macaron_adaln"


def _rmsnorm(x, g):
    x32 = x.astype(jnp.float32)
    y = x32 * lax.rsqrt(jnp.mean(x32 * x32, axis=-1, keepdims=True) + EPS)
    return y.astype(x.dtype) * g


def _layernorm(x, g, b):
    x32 = x.astype(jnp.float32)
    mu = jnp.mean(x32, axis=-1, keepdims=True)
    var = jnp.mean(jnp.square(x32 - mu), axis=-1, keepdims=True)
    return ((x32 - mu) * lax.rsqrt(var + EPS)).astype(x.dtype) * g + b


def _rope_tables(pos):
    inv = 1.0 / (ROPE_THETA ** (jnp.arange(0, HEAD_DIM, 2, dtype=jnp.float32) / HEAD_DIM))
    ang = pos.astype(jnp.float32)[:, None] * inv[None, :]
    return jnp.cos(ang), jnp.sin(ang)


def _rope(x, cos, sin):
    x32 = x.astype(jnp.float32)
    x1, x2 = jnp.split(x32, 2, axis=-1)
    c = cos[None, :, None, :]
    s = sin[None, :, None, :]
    return jnp.concatenate([x1 * c - x2 * s, x2 * c + x1 * s], axis=-1).astype(x.dtype)


def _modulate(xn, shift, scale):
    return xn * (1.0 + scale) + shift


def _swiglu(x, w_in, w_out):
    a, b = jnp.split(x @ w_in, 2, axis=-1)
    return (jax.nn.silu(a) * b) @ w_out


def _nsa(q, k_cmp, v_cmp, k_sel, v_sel, k_win, v_win, gates, pe, w1, w2):
    B, S = q.shape[0], q.shape[1]
    G, HG = NSA_KV_GROUPS, NSA_HPG
    scale = HEAD_DIM ** -0.5
    pos = jnp.arange(S, dtype=jnp.int32)
    cos, sin = _rope_tables(pos)
    qr = _rope(q, cos, sin).reshape(B, S, G, HG, HEAD_DIM)

    n_cmp = (S - CMP_BLOCK) // CMP_STRIDE + 1
    starts = jnp.arange(n_cmp, dtype=jnp.int32) * CMP_STRIDE
    win_idx = starts[:, None] + jnp.arange(CMP_BLOCK, dtype=jnp.int32)[None, :]

    def compress(t, j):
        blk = t[:, win_idx] + pe[j][None, None, :, None, :]
        h = jax.nn.silu(jnp.einsum('bnlgd,ldf->bngf', blk, w1[j]))
        return h @ w2[j]

    kc = compress(k_cmp, 0)
    vc = compress(v_cmp, 1)
    cend = starts + CMP_BLOCK - 1
    ccos, csin = _rope_tables(cend)
    kc = _rope(kc, ccos, csin)
    s_c = jnp.einsum('bsghd,bngd->bsghn', qr, kc).astype(jnp.float32) * scale
    m_c = (cend[None, :] <= pos[:, None])[None, :, None, None, :]
    p_c = jax.nn.softmax(jnp.where(m_c, s_c, NEG), axis=-1) * m_c
    o_cmp = jnp.einsum('bsghn,bngd->bsghd', p_c.astype(vc.dtype), vc)

    n_sel = S // SEL_BLOCK
    top = min(SEL_TOPK, n_sel)
    sel_start = jnp.arange(n_sel, dtype=jnp.int32) * SEL_BLOCK
    overlap = jnp.clip(
        jnp.minimum(starts[:, None] + CMP_BLOCK, sel_start[None, :] + SEL_BLOCK)
        - jnp.maximum(starts[:, None], sel_start[None, :]), 0, None
    ).astype(jnp.float32) / CMP_BLOCK
    imp = jnp.einsum('bsgn,nj->bsgj', jnp.sum(p_c, axis=3), overlap)
    cur = pos // SEL_BLOCK
    blk = jnp.arange(n_sel, dtype=jnp.int32)
    forced = (blk[None, :] == 0) | (blk[None, :] == cur[:, None]) | (blk[None, :] == cur[:, None] - 1)
    valid = blk[None, :] <= cur[:, None]
    imp = jnp.where(forced[None, :, None, :], FORCE,
                    jnp.where(valid[None, :, None, :], imp, -FORCE))
    _, sel_idx = lax.top_k(imp, top)
    sel_idx = sel_idx.transpose(0, 2, 1, 3)

    ks = _rope(k_sel, cos, sin).reshape(B, n_sel, SEL_BLOCK, G, HEAD_DIM).transpose(0, 3, 1, 2, 4)
    vs = v_sel.reshape(B, n_sel, SEL_BLOCK, G, HEAD_DIM).transpose(0, 3, 1, 2, 4)
    pad = ((0, 0), (WINDOW, 0), (0, 0), (0, 0))
    kw = jnp.pad(_rope(k_win, cos, sin), pad)
    vw = jnp.pad(v_win, pad)
    bi = jnp.arange(B)[:, None, None, None]
    gi = jnp.arange(G)[None, :, None, None]
    jj = jnp.arange(SEL_BLOCK, dtype=jnp.int32)
    wj = jnp.arange(Q_BLOCK + WINDOW, dtype=jnp.int32)

    def block(qb):
        q0 = qb * Q_BLOCK
        qq = lax.dynamic_slice_in_dim(qr, q0, Q_BLOCK, axis=1)
        tq = q0 + jnp.arange(Q_BLOCK, dtype=jnp.int32)
        idx = lax.dynamic_slice_in_dim(sel_idx, q0, Q_BLOCK, axis=2)
        kg = ks[bi, gi, idx]
        vg = vs[bi, gi, idx]
        s = jnp.einsum('bqghd,bgqnjd->bgqhnj', qq, kg).astype(jnp.float32) * scale
        kpos = idx[..., None] * SEL_BLOCK + jj
        m = (kpos <= tq[None, None, :, None, None])[:, :, :, None]
        s = jnp.where(m, s, NEG).reshape(B, G, Q_BLOCK, HG, top * SEL_BLOCK)
        p = jax.nn.softmax(s, axis=-1).reshape(B, G, Q_BLOCK, HG, top, SEL_BLOCK)
        o_s = jnp.einsum('bgqhnj,bgqnjd->bqghd', p.astype(vg.dtype), vg)
        kk = lax.dynamic_slice_in_dim(kw, q0, Q_BLOCK + WINDOW, axis=1)
        vv = lax.dynamic_slice_in_dim(vw, q0, Q_BLOCK + WINDOW, axis=1)
        kp = q0 - WINDOW + wj
        d = tq[:, None] - kp[None, :]
        mw = ((d >= 0) & (d < WINDOW) & (kp[None, :] >= 0))[None, :, None, None, :]
        sw = jnp.einsum('bqghd,bkgd->bqghk', qq, kk).astype(jnp.float32) * scale
        pw = jax.nn.softmax(jnp.where(mw, sw, NEG), axis=-1)
        o_w = jnp.einsum('bqghk,bkgd->bqghd', pw.astype(vv.dtype), vv)
        return o_s, o_w

    o_sel, o_win = lax.map(block, jnp.arange(S // Q_BLOCK, dtype=jnp.int32))
    o_sel = o_sel.transpose(1, 0, 2, 3, 4, 5).reshape(B, S, G, HG, HEAD_DIM)
    o_win = o_win.transpose(1, 0, 2, 3, 4, 5).reshape(B, S, G, HG, HEAD_DIM)
    g = gates.reshape(B, S, G, HG, 3)
    o = g[..., 0:1] * o_cmp + g[..., 1:2] * o_sel + g[..., 2:3] * o_win
    return o.reshape(B, S, NSA_WIDTH)


def _gmlp(uv, ln_g, ln_b, ws, bs):
    B, S = uv.shape[0], uv.shape[1]
    u, v = jnp.split(jax.nn.gelu(uv), 2, axis=-1)
    v = _layernorm(v, ln_g, ln_b)
    v = v.reshape(B, S // GM_CHUNK, GM_CHUNK, GM_GROUPS, HEAD_DIM)
    w = ws * jnp.tril(jnp.ones((GM_CHUNK, GM_CHUNK), ws.dtype))
    sv = jnp.einsum('gts,bnsgc->bntgc', w, v) + bs.T[None, None, :, :, None]
    return u * sv.reshape(B, S, GM_WIDTH)


def setup_inputs(seed: int = 0) -> dict:
    key = jax.random.key(seed)
    k = jax.random.split(key, 24)
    L, D = DEPTH, D_MODEL

    def nrm(kk, shape, scale):
        return jax.random.normal(kk, shape, jnp.float32) * scale

    return {
        "x": nrm(k[0], (BATCH, SEQ, D), 1.0),
        "c": nrm(k[1], (BATCH, D), 1.0),
        "ada_w": nrm(k[2], (L, D, 9 * D), 0.5 * D ** -0.5),
        "ada_b": nrm(k[3], (L, 9 * D), 0.1),
        "norm_g": 1.0 + nrm(k[4], (L, 3, D), 0.1),
        "ffn_w_in": nrm(k[5], (L, 2, D, 2 * D_FF), D ** -0.5),
        "ffn_w_out": nrm(k[6], (L, 2, D_FF, D), D_FF ** -0.5),
        "mix_w_in": nrm(k[7], (L, D, IN_WIDTH), D ** -0.5),
        "cmp_pe": nrm(k[8], (L, 2, CMP_BLOCK, HEAD_DIM), 0.1),
        "cmp_w1": nrm(k[9], (L, 2, CMP_BLOCK, HEAD_DIM, CMP_HIDDEN), (CMP_BLOCK * HEAD_DIM) ** -0.5),
        "cmp_w2": nrm(k[10], (L, 2, CMP_HIDDEN, HEAD_DIM), CMP_HIDDEN ** -0.5),
        "gm_ln_g": 1.0 + nrm(k[11], (L, GM_WIDTH), 0.1),
        "gm_ln_b": nrm(k[12], (L, GM_WIDTH), 0.1),
        "gm_ws": nrm(k[13], (L, GM_GROUPS, GM_CHUNK, GM_CHUNK), GM_CHUNK ** -0.5),
        "gm_bs": 1.0 + nrm(k[14], (L, GM_GROUPS, GM_CHUNK), 0.1),
        "proj_a": nrm(k[15], (L, NSA_WIDTH, D), NSA_WIDTH ** -0.5),
        "proj_b": nrm(k[16], (L, GM_WIDTH, D), GM_WIDTH ** -0.5),
        "w_out": nrm(k[17], (L, D, D), D ** -0.5),
        "final_g": 1.0 + nrm(k[18], (D,), 0.1),
    }


def reference(x, c, ada_w, ada_b, norm_g, ffn_w_in, ffn_w_out, mix_w_in, cmp_pe, cmp_w1,
              cmp_w2, gm_ln_g, gm_ln_b, gm_ws, gm_bs, proj_a, proj_b, w_out, final_g):
    B, S, D = x.shape
    h = x
    for l in range(DEPTH):
        mod = (jax.nn.silu(c) @ ada_w[l] + ada_b[l]).reshape(B, 3, 3, 1, D)

        n = _modulate(_rmsnorm(h, norm_g[l, 0]), mod[:, 0, 0], mod[:, 0, 1])
        h = h + 0.5 * mod[:, 0, 2] * _swiglu(n, ffn_w_in[l, 0], ffn_w_out[l, 0])

        n = _modulate(_rmsnorm(h, norm_g[l, 1]), mod[:, 1, 0], mod[:, 1, 1])
        z = n @ mix_w_in[l]
        zq, zkv, zg, zuv, zga, zgb = jnp.split(z, IN_SPLITS, axis=-1)
        q = zq.reshape(B, S, NSA_HEADS, HEAD_DIM)
        kv = zkv.reshape(B, S, 6, NSA_KV_GROUPS, HEAD_DIM)
        nsa_gates = jax.nn.sigmoid(zg).reshape(B, S, NSA_HEADS, 3)
        y_a = _nsa(q, kv[:, :, 0], kv[:, :, 1], kv[:, :, 2], kv[:, :, 3], kv[:, :, 4], kv[:, :, 5],
                   nsa_gates, cmp_pe[l], cmp_w1[l], cmp_w2[l])
        y_b = _gmlp(zuv, gm_ln_g[l], gm_ln_b[l], gm_ws[l], gm_bs[l])
        merged = jax.nn.sigmoid(zga) * (y_a @ proj_a[l]) + jax.nn.sigmoid(zgb) * (y_b @ proj_b[l])
        h = h + mod[:, 1, 2] * (merged @ w_out[l])

        n = _modulate(_rmsnorm(h, norm_g[l, 2]), mod[:, 2, 0], mod[:, 2, 1])
        h = h + 0.5 * mod[:, 2, 2] * _swiglu(n, ffn_w_in[l, 1], ffn_w_out[l, 1])
    return _rmsnorm(h, final_g)
```

```cpp
#include <hip/hip_runtime.h>
#include <hip/hip_cooperative_groups.h>
#include <cstdio>
#include <cstdint>
namespace cg = cooperative_groups;
namespace pg8 {
#define PG8_LAS __attribute__((address_space(3)))
typedef unsigned short bf16_t;
typedef short bf16x8 __attribute__((ext_vector_type(8)));
typedef float f32x4 __attribute__((ext_vector_type(4)));
typedef unsigned u32x4 __attribute__((ext_vector_type(4)));
constexpr int BM = 256, BK = 64, HALF = 128, HTB = HALF * BK * 2  , STAGE_BYTES = 8 * HTB, NXCD = 8, WGM = 8;

__host__ __device__ __forceinline__ int lds_byte(int r, int c) { const int st = (r >> 4) * 2 + (c >> 5), rr = r & 15, cc = c & 31, ob = rr * 64 + cc * 2; return st * 1024 + (ob ^ (((ob >> 9) & 1) << 5)); }
__host__ __device__ __forceinline__ void stage_rc(int b, int& R, int& C) { const int st = b / 1024, sb = b % 1024, swz = sb ^ (((sb >> 9) & 1) << 5); R = (st >> 1) * 16 + swz / 64; C = (st & 1) * 32 + (swz % 64) / 2; }
__host__ __device__ __forceinline__ int perm32(int rho) { const int n = rho >> 4, i = rho & 15; return 8 * (i >> 2) + 4 * n + (i & 3); }

struct Unit { int pm, pn; };
struct Gemm { const bf16_t* A; const bf16_t* Bt; int M, N, K; int a_tiled, b_tiled; };

struct StaticOrder {
    int nM, nN, nwg, G, c;
    __host__ __device__ void init(int M, int N, int G_, int c_) { nM = M / BM; nN = N / BM; nwg = nM * nN; G = G_; c = c_; }
    __host__ __device__ bool next(int i, Unit& u) const {
        const long L = (long)i * G + c; if (L >= nwg) return false;
        int wgid = (int)L; { const int q = nwg / NXCD, r = nwg % NXCD, xcd = wgid % NXCD, off = wgid / NXCD; wgid = (xcd < r ? xcd * (q + 1) : r * (q + 1) + (xcd - r) * q) + off; }
        const int nig = WGM * nN, gid = wgid / nig, fm = gid * WGM, gsz = (nM - fm) < WGM ? (nM - fm) : WGM;
        u.pm = fm + ((wgid % nig) % gsz); u.pn = (wgid % nig) / gsz; return true;
    }
    __device__ __forceinline__ void a_ready(const Unit&) const {}
    __device__ __forceinline__ void done(const Unit&) const {}
};

__device__ __forceinline__ unsigned cvt_pk_bf16(float lo, float hi) { unsigned r; asm volatile("v_cvt_pk_bf16_f32 %0, %1, %2" : "=v"(r) : "v"(lo), "v"(hi)); return r; }
template <class Epi, class Sched, bool ALIGN_EPI = false, bool SP2 = false>
__device__ __forceinline__ void gemm_phase(PG8_LAS unsigned char* lds, const Gemm g, const Sched& S, const Epi& E, const int tid_in) {
    const int tid = tid_in, wid = __builtin_amdgcn_readfirstlane(tid >> 6), lane = tid & 63, wr = wid >> 2, wc = wid & 3, fr = lane & 15, fq = lane >> 4;
    const int K = g.K, nt = K / BK;
    unsigned voffA[2], voffB[2];
#pragma unroll
    for (int i = 0; i < 2; ++i) { int R, C; stage_rc(tid * 16 + i * 8192, R, C); const int Rb = Epi::PERM ? ((R & ~31) + perm32(R & 31)) : R;
        voffA[i] = (unsigned)(R * (g.a_tiled ? BK : K) + C) * 2u; voffB[i] = (unsigned)(Rb * (g.b_tiled ? BK : K) + C) * 2u; }
    const size_t kstep = (size_t)(BK * 2);
    const size_t hstep = (size_t)HALF * K * 2;
    const size_t tstep = 2 * hstep;
    const size_t kstepA = g.a_tiled ? (size_t)BM * BK * 2 : kstep, hstepA = g.a_tiled ? (size_t)HALF * BK * 2 : hstep, tstepA = g.a_tiled ? (size_t)(K / BK) * BM * BK * 2 : tstep;
    const size_t kstepB = g.b_tiled ? (size_t)BM * BK * 2 : kstep, hstepB = g.b_tiled ? (size_t)HALF * BK * 2 : hstep, tstepB = g.b_tiled ? (size_t)(K / BK) * BM * BK * 2 : tstep;
    const unsigned ldsw = (unsigned)wid * 1024u;
    const int aoff = lds_byte(wr * 64 + fr, fq * 8), boff = lds_byte(wc * 32 + fr, fq * 8);
#define PG8_SA(b, h) (((b) * 2 + (h)) * HTB)
#define PG8_SB(b, h) ((4 + (b) * 2 + (h)) * HTB)
#define PG8_STAGE(bufoff, gbase, voff) do { _Pragma("unroll") for (int _i = 0; _i < 2; ++_i) \
        __builtin_amdgcn_global_load_lds((const unsigned*)((const char*)(gbase) + (voff)[_i]), (PG8_LAS unsigned*)(lds + (bufoff) + ldsw + _i * 8192), 16, 0, 0); } while (0)
#define PG8_LDA(dst, b, h) do { _Pragma("unroll") for (int m = 0; m < 4; ++m) _Pragma("unroll") for (int k = 0; k < 2; ++k) dst[m][k] = *(const PG8_LAS bf16x8*)(lds + PG8_SA(b, h) + aoff + m * 2048 + k * 1024); } while (0)
#define PG8_LDB(dst, b, h) do { _Pragma("unroll") for (int n = 0; n < 2; ++n) _Pragma("unroll") for (int k = 0; k < 2; ++k) dst[n][k] = *(const PG8_LAS bf16x8*)(lds + PG8_SB(b, h) + boff + n * 2048 + k * 1024); } while (0)
#define PG8_MMA(ai, bj, At, Bt) do { __builtin_amdgcn_s_setprio(1); _Pragma("unroll") for (int m = 0; m < 4; ++m) _Pragma("unroll") for (int n = 0; n < 2; ++n) _Pragma("unroll") for (int k = 0; k < 2; ++k) \
        acc[ai][bj][m][n] = __builtin_amdgcn_mfma_f32_16x16x32_bf16(Bt[n][k], At[m][k], acc[ai][bj][m][n], 0, 0, 0); __builtin_amdgcn_s_setprio(0); } while (0)
#define PG8_WAIT_V(n) asm volatile("s_waitcnt vmcnt(" #n ")" ::: "memory")
#define PG8_WAIT_L(n) asm volatile("s_waitcnt lgkmcnt(" #n ")" ::: "memory")
#define PG8_BAR __builtin_amdgcn_s_barrier()
#define PG8_SCHED __builtin_amdgcn_sched_barrier(0)
    Unit cur, nxt; int ui = 0;
    if (!S.next(0, cur)) return;
    f32x4 acc[2][2][4][2];
#pragma unroll
    for (int a = 0; a < 2; ++a)
#pragma unroll
        for (int b = 0; b < 2; ++b)
#pragma unroll
            for (int m = 0; m < 4; ++m)
#pragma unroll
                for (int n = 0; n < 2; ++n) acc[a][b][m][n] = (f32x4){0.f, 0.f, 0.f, 0.f};
    bf16x8 At[4][2], B0[2][2], B1[2][2];
    const char* cA = (const char*)g.A + (size_t)cur.pm * tstepA; const char* cB = (const char*)g.Bt + (size_t)cur.pn * tstepB;
    S.a_ready(cur);
    if constexpr (SP2) {
        PG8_STAGE(PG8_SB(0, 0), cB, voffB); PG8_STAGE(PG8_SB(0, 1), cB + hstepB, voffB); PG8_STAGE(PG8_SA(0, 0), cA, voffA); PG8_STAGE(PG8_SA(0, 1), cA + hstepA, voffA);
        if (wr == 1) PG8_BAR;
        PG8_WAIT_V(2); PG8_BAR;
        PG8_STAGE(PG8_SB(1, 0), cB + kstepB, voffB); PG8_STAGE(PG8_SA(1, 0), cA + kstepA, voffA); PG8_STAGE(PG8_SB(1, 1), cB + hstepB + kstepB, voffB);
        PG8_WAIT_V(6); PG8_BAR;
    } else {
        PG8_STAGE(PG8_SB(0, 0), cB, voffB); PG8_STAGE(PG8_SA(0, 0), cA, voffA); PG8_STAGE(PG8_SB(0, 1), cB + hstepB, voffB); PG8_STAGE(PG8_SA(0, 1), cA + hstepA, voffA);
        if (wr == 1) PG8_BAR;
        PG8_WAIT_V(4); PG8_BAR;
        PG8_STAGE(PG8_SB(1, 0), cB + kstepB, voffB); PG8_STAGE(PG8_SA(1, 0), cA + kstepA, voffA); PG8_STAGE(PG8_SB(1, 1), cB + hstepB + kstepB, voffB);
        PG8_WAIT_V(6); PG8_BAR;
    }
    for (;;) {
        const bool has_next = S.next(ui + 1, nxt);
        const char* nA = has_next ? (const char*)g.A + (size_t)nxt.pm * tstepA : cA; const char* nB = has_next ? (const char*)g.Bt + (size_t)nxt.pn * tstepB : cB;
        for (int t = 0; t < nt; t += 2) {
            const bool last = (t == nt - 2);
            const char* a1 = cA + (size_t)(t + 1) * kstepA;
            const char* a2 = last ? nA : cA + (size_t)(t + 2) * kstepA; const char* b2 = last ? nB : cB + (size_t)(t + 2) * kstepB;
            const char* a3 = a2 + kstepA; const char* b3 = b2 + kstepB;
            if (last && has_next) S.a_ready(nxt);
            if constexpr (SP2) {
            PG8_LDB(B0, 0, 0); PG8_LDB(B1, 0, 1); PG8_SCHED; PG8_LDA(At, 0, 0); PG8_STAGE(PG8_SA(1, 1), a1 + hstepA, voffA);
            PG8_WAIT_V(8); PG8_WAIT_L(0); PG8_BAR; PG8_MMA(0, 0, At, B0); PG8_MMA(0, 1, At, B1); PG8_BAR; PG8_SCHED;
            PG8_LDA(At, 0, 1); PG8_STAGE(PG8_SB(0, 0), b2, voffB); PG8_STAGE(PG8_SB(0, 1), b2 + hstepB, voffB); PG8_STAGE(PG8_SA(0, 0), a2, voffA);
            PG8_WAIT_V(8); PG8_WAIT_L(0); PG8_BAR; PG8_MMA(1, 0, At, B0); PG8_MMA(1, 1, At, B1); PG8_BAR; PG8_SCHED;
            PG8_LDB(B0, 1, 0); PG8_LDB(B1, 1, 1); PG8_SCHED; PG8_LDA(At, 1, 0); PG8_STAGE(PG8_SA(0, 1), a2 + hstepA, voffA);
            PG8_WAIT_V(8); PG8_WAIT_L(0); PG8_BAR; PG8_MMA(0, 0, At, B0); PG8_MMA(0, 1, At, B1); PG8_BAR; PG8_SCHED;
            PG8_LDA(At, 1, 1); PG8_STAGE(PG8_SB(1, 0), b3, voffB); PG8_STAGE(PG8_SB(1, 1), b3 + hstepB, voffB); PG8_STAGE(PG8_SA(1, 0), a3, voffA);
            PG8_WAIT_V(8); PG8_WAIT_L(0); PG8_BAR; PG8_MMA(1, 0, At, B0); PG8_MMA(1, 1, At, B1); PG8_BAR; PG8_SCHED;
            } else {
            PG8_LDB(B0, 0, 0); PG8_SCHED; PG8_LDA(At, 0, 0); PG8_STAGE(PG8_SA(1, 1), a1 + hstepA, voffA);
            PG8_WAIT_L(8); PG8_BAR; PG8_WAIT_L(0); PG8_MMA(0, 0, At, B0); PG8_BAR; PG8_SCHED;
            PG8_LDB(B1, 0, 1); PG8_STAGE(PG8_SB(0, 0), b2, voffB);
            PG8_BAR; PG8_WAIT_L(0); PG8_MMA(0, 1, At, B1); PG8_BAR;
            PG8_LDA(At, 0, 1); PG8_STAGE(PG8_SA(0, 0), a2, voffA);
            PG8_BAR; PG8_WAIT_L(0); PG8_MMA(1, 0, At, B0); PG8_BAR; PG8_SCHED;
            PG8_STAGE(PG8_SB(0, 1), b2 + hstepB, voffB);
            PG8_WAIT_V(6); PG8_BAR; PG8_MMA(1, 1, At, B1); PG8_BAR;
            PG8_LDB(B0, 1, 0); PG8_SCHED; PG8_LDA(At, 1, 0); PG8_STAGE(PG8_SA(0, 1), a2 + hstepA, voffA);
            PG8_WAIT_L(8); PG8_BAR; PG8_WAIT_L(0); PG8_MMA(0, 0, At, B0); PG8_BAR; PG8_SCHED;
            PG8_LDB(B1, 1, 1); PG8_STAGE(PG8_SB(1, 0), b3, voffB);
            PG8_BAR; PG8_WAIT_L(0); PG8_MMA(0, 1, At, B1); PG8_BAR;
            PG8_LDA(At, 1, 1); PG8_STAGE(PG8_SA(1, 0), a3, voffA);
            PG8_BAR; PG8_WAIT_L(0); PG8_MMA(1, 0, At, B0); PG8_BAR; PG8_SCHED;
            PG8_STAGE(PG8_SB(1, 1), b3 + hstepB, voffB);
            PG8_WAIT_V(6); PG8_BAR; PG8_MMA(1, 1, At, B1); PG8_BAR;
            }
        }
        if constexpr (ALIGN_EPI) { if (wr == 0) PG8_BAR; }
        if constexpr (!Epi::AFTER_DRAIN) { E(acc, cur, wr, wc, fr, fq); S.done(cur); }
        if (!has_next) break;
#pragma unroll
        for (int a = 0; a < 2; ++a)
#pragma unroll
            for (int b = 0; b < 2; ++b)
#pragma unroll
                for (int m = 0; m < 4; ++m)
#pragma unroll
                    for (int n = 0; n < 2; ++n) acc[a][b][m][n] = (f32x4){0.f, 0.f, 0.f, 0.f};
        cur = nxt; cA = nA; cB = nB; ++ui;
        if constexpr (ALIGN_EPI) { if (wr == 1) PG8_BAR; }
    }
    PG8_WAIT_V(0);
    if constexpr (!ALIGN_EPI) { if (wr == 0) PG8_BAR; }
    PG8_BAR;
    if constexpr (Epi::AFTER_DRAIN) { E.fused(acc, cur, wr, wc, fr, fq, lds, wid, lane); S.done(cur); }
#undef PG8_SA
#undef PG8_SB
#undef PG8_STAGE
#undef PG8_LDA
#undef PG8_LDB
#undef PG8_MMA
#undef PG8_WAIT_V
#undef PG8_WAIT_L
#undef PG8_BAR
#undef PG8_SCHED
}
}

constexpr int BATCH = 8, SEQ = 2048, DM = 1024, MROWS = BATCH * SEQ, DFF = 2816, NFF2 = 2 * DFF, NINP = 4608, NIN = 4376;
constexpr int NWAVES = 8, NTHR = 512;
constexpr int LDS_BYTES = 147456;
constexpr int N_PHASES = 26;
#ifndef EN
#define EN 511
#endif
#ifndef FUSE_NORM
#define FUSE_NORM 1
#endif
#ifndef PROBE_REP
#define PROBE_REP 0
#endif
#ifndef PROBE_SYNC
#define PROBE_SYNC 0
#endif
constexpr float QSCALE = 0.125f * 1.4426950408889634f;
#define LAS __attribute__((address_space(3)))
typedef unsigned short bf16_t;
typedef short bf16x8 __attribute__((ext_vector_type(8)));
typedef short s16x4 __attribute__((ext_vector_type(4)));
typedef float f32x4 __attribute__((ext_vector_type(4)));
typedef float f32x16 __attribute__((ext_vector_type(16)));
typedef unsigned u32x2 __attribute__((ext_vector_type(2)));
typedef unsigned u32x4 __attribute__((ext_vector_type(4)));
#define MFMA32(a, b, c) __builtin_amdgcn_mfma_f32_32x32x16_bf16((a), (b), (c), 0, 0, 0)

constexpr size_t MiB = 1u << 20;
constexpr size_t WS_MODP = 0;
constexpr size_t WS_BAR = 4 * MiB + 768 * 1024;
constexpr size_t WS_CNT = WS_BAR + 16384;
constexpr size_t WS_XT = WS_CNT + 24576;
constexpr size_t WS_ROPE = 5 * MiB;
constexpr size_t WS_PECP = 5 * MiB + 768 * 1024;
constexpr size_t WS_W1T = 6 * MiB;
constexpr size_t WS_KC = 8 * MiB;
constexpr size_t WS_VC = 8 * MiB + 512 * 1024;
constexpr size_t WS_WFI = 10 * MiB;
constexpr size_t WS_WFO = 54 * MiB;
constexpr size_t WS_WMIX = 76 * MiB;
constexpr size_t WS_WPA = 94 * MiB;
constexpr size_t WS_WPB = 96 * MiB;
constexpr size_t WS_WO = 98 * MiB;
constexpr size_t WS_XN = 102 * MiB;
constexpr size_t WS_YA = 102 * MiB, WS_YB = 118 * MiB;
constexpr size_t WS_HID = 134 * MiB;
constexpr size_t WS_QR = 134 * MiB;
constexpr size_t WS_KV = 150 * MiB;
constexpr size_t WS_EW = 176 * MiB;
constexpr size_t WS_GATES = 272 * MiB;
constexpr size_t WS_MG = 134 * MiB;
constexpr size_t WS_END = 274 * MiB;

struct Args { const float* in[19]; float* out; unsigned char* ws; int ph_lo, ph_hi; };
typedef const __attribute__((address_space(4))) Args* CArgsP;

__device__ __forceinline__ unsigned pk2(float lo, float hi) {
    typedef float f2 __attribute__((ext_vector_type(2))); typedef __bf16 b2 __attribute__((ext_vector_type(2)));
    f2 v = {lo, hi}; b2 b = __builtin_convertvector(v, b2); return __builtin_bit_cast(unsigned, b);
}
__device__ __forceinline__ float bf_lo(unsigned u) { return __uint_as_float(u << 16); }
__device__ __forceinline__ float bf_hi(unsigned u) { return __uint_as_float(u & 0xffff0000u); }
__device__ __forceinline__ float fexp2(float x) { return __builtin_amdgcn_exp2f(x); }
__device__ __forceinline__ float frcp(float x) { return __builtin_amdgcn_rcpf(x); }
__device__ __forceinline__ float sigm(float x) { return frcp(1.f + fexp2(-1.4426950408889634f * x)); }
__device__ __forceinline__ float silu_f(float x) { return x * sigm(x); }
__device__ __forceinline__ float gelu_tanh_f(float x) { return x * sigm(1.5957691216057308f * (x + 0.044715f * x * x * x)); }
__device__ __forceinline__ float wave_sum(float v) {
#pragma unroll
    for (int o = 1; o < 64; o <<= 1) v += __shfl_xor(v, o);
    return v;
}
__device__ __forceinline__ int crow(int r, int hi) { return (r & 3) + 8 * (r >> 2) + 4 * hi; }
__device__ __forceinline__ s16x4 tr_read(LAS unsigned char* p) { return __builtin_amdgcn_ds_read_tr16_b64_v4i16((LAS s16x4*)p); }
__device__ __forceinline__ bf16x8 cat8(s16x4 a, s16x4 b) { return __builtin_shufflevector(a, b, 0, 1, 2, 3, 4, 5, 6, 7); }
#define PACK8(S, sp) ({ u32x4 _p; _p.x = pk2((S)[8 * (sp) + 0], (S)[8 * (sp) + 1]); _p.y = pk2((S)[8 * (sp) + 2], (S)[8 * (sp) + 3]); \
                        _p.z = pk2((S)[8 * (sp) + 4], (S)[8 * (sp) + 5]); _p.w = pk2((S)[8 * (sp) + 6], (S)[8 * (sp) + 7]); __builtin_bit_cast(bf16x8, _p); })

__device__ __forceinline__ unsigned xb_xcc_id();
__device__ __forceinline__ f32x4 modv4(const float* modp, const float* adab, int l, int b, int idx) {
    f32x4 s = *(const f32x4*)(adab + l * 9216 + idx);
#pragma unroll
    for (int kc = 0; kc < 8; ++kc) s += *(const f32x4*)(modp + (size_t)((l * 8 + kc) * 8 + b) * 9216 + idx);
    return s;
}

__device__ __forceinline__ int rowmap(int mode, int n) {
    if (mode == 1) { return n < DFF ? ((n >> 7) * 256 + (n & 127)) : (((n - DFF) >> 7) * 256 + 128 + ((n - DFF) & 127)); }
    if (mode == 2) {
        if (n >= 1304) return n - 24;
        if (n >= 1280) return 4352 + (n - 1280);
        { const int d = n & 63; return (n & ~63) | (((d >> 4) & 1) << 5) | (((d >> 2) & 3) << 3) | ((d >> 5) << 2) | (d & 3); }
    }
    return n;
}
__device__ __forceinline__ void tr_item(const float* W, int K, int N, bf16_t* WT, int mode, LAS float* scr, int item, int lane, int tiled = 1) {
    const int nblk = (N + 31) / 32, kb = item / nblk, nb = item % nblk, k0 = 64 * kb, n0 = 32 * nb;
    const int nn = n0 + (lane & 31);
    float tv[32];
    const float* wp = W + (size_t)(k0 + (lane >> 5)) * N + (nn < N ? nn : 0);
#pragma unroll
    for (int i = 0; i < 32; ++i) tv[i] = wp[(size_t)(2 * i) * N];
#pragma unroll
    for (int i = 0; i < 32; ++i) scr[(2 * i + (lane >> 5)) * 33 + (lane & 31)] = (nn < N) ? tv[i] : 0.f;
    asm volatile("s_waitcnt lgkmcnt(0)" ::: "memory");
    const int c = lane & 7;
#pragma unroll
    for (int j = 0; j < 4; ++j) {
        const int n = (lane >> 3) + 8 * j; const LAS float* s = scr + (8 * c) * 33 + n;
        u32x4 o; o.x = pk2(s[0 * 33], s[1 * 33]); o.y = pk2(s[2 * 33], s[3 * 33]); o.z = pk2(s[4 * 33], s[5 * 33]); o.w = pk2(s[6 * 33], s[7 * 33]);
        if (n0 + n < N) {
            const int pr = rowmap(mode, n0 + n);
            const size_t off = tiled ? ((size_t)((pr >> 8) * (K >> 6) + (k0 >> 6)) * 256 + (pr & 255)) * 64 + 8 * c : (size_t)pr * K + k0 + 8 * c;
            *(u32x4*)(WT + off) = o;
        }
    }
    asm volatile("s_waitcnt lgkmcnt(0)" ::: "memory");
}

constexpr int I_FI = 16 * 176, I_FO = 44 * 32, I_MIX = 16 * 137, I_P = 8 * 32, I_O = 16 * 32, I_W1 = 32 * 4;
constexpr int LAYER_ITEMS = 1152 + 2 * I_FI + 2 * I_FO + I_MIX + 2 * I_P + I_O + 2 * I_W1 + 64;
#ifndef BG_PREP
#define BG_PREP 1
#endif
__device__ __forceinline__ void prep_sc(CArgsP a, LAS unsigned char* lds, int tid) {
    LAS float* SC = (LAS float*)lds; const float* c = a->in[1];
    __syncthreads();
    for (int i = tid; i < 8192; i += NTHR) { const float v = c[i]; SC[i] = silu_f(v); }
    __syncthreads();
}
__device__ __forceinline__ void prep_items(CArgsP a, LAS unsigned char* lds, int l, int lo, int hi, int first, int stride, int wave, int lane) {
    LAS float* SC = (LAS float*)lds;
    LAS float* scr = (LAS float*)(lds + 32768 + wave * 8448);
    bf16_t* WFI = (bf16_t*)(a->ws + WS_WFI); bf16_t* WFO = (bf16_t*)(a->ws + WS_WFO); bf16_t* WMIX = (bf16_t*)(a->ws + WS_WMIX);
    bf16_t* WPA = (bf16_t*)(a->ws + WS_WPA); bf16_t* WPB = (bf16_t*)(a->ws + WS_WPB); bf16_t* WO = (bf16_t*)(a->ws + WS_WO); bf16_t* W1T = (bf16_t*)(a->ws + WS_W1T);
    for (int it = lo + first; it < hi; it += stride) {
        int r = it;
        if (r < 1152) {
            const float* ada_w = a->in[2]; float* modp = (float*)(a->ws + WS_MODP);
            const int cb = r >> 3, kc = r & 7, col = cb * 64 + lane;
            const float* W = ada_w + (size_t)l * 1024 * 9216 + col;
            float acc[8];
#pragma unroll
            for (int b = 0; b < 8; ++b) acc[b] = 0.f;
            for (int k16 = 0; k16 < 8; ++k16) {
                const int kb = kc * 128 + k16 * 16;
                float wv[16];
#pragma unroll
                for (int i = 0; i < 16; ++i) wv[i] = W[(size_t)(kb + i) * 9216];
#pragma unroll
                for (int i4 = 0; i4 < 4; ++i4)
#pragma unroll
                    for (int b = 0; b < 8; ++b) { const f32x4 sv = *(const LAS f32x4*)(SC + b * 1024 + kb + 4 * i4); acc[b] += sv.x * wv[4 * i4] + sv.y * wv[4 * i4 + 1] + sv.z * wv[4 * i4 + 2] + sv.w * wv[4 * i4 + 3]; }
            }
#pragma unroll
            for (int b = 0; b < 8; ++b) modp[(size_t)((l * 8 + kc) * 8 + b) * 9216 + col] = acc[b];
            continue;
        }
        r -= 1152;
        if (r < 2 * I_FI) { const int w = l * 2 + r / I_FI; tr_item(a->in[5] + (size_t)w * 1024 * NFF2, 1024, NFF2, WFI + (size_t)w * NFF2 * 1024, 1, scr, r % I_FI, lane); continue; } r -= 2 * I_FI;
        if (r < 2 * I_FO) { const int w = l * 2 + r / I_FO; tr_item(a->in[6] + (size_t)w * DFF * 1024, DFF, 1024, WFO + (size_t)w * 1024 * DFF, 0, scr, r % I_FO, lane); continue; } r -= 2 * I_FO;
        if (r < I_MIX) { tr_item(a->in[7] + (size_t)l * 1024 * NIN, 1024, NIN, WMIX + (size_t)l * NINP * 1024, 2, scr, r, lane); continue; } r -= I_MIX;
        if (r < I_P) { tr_item(a->in[15] + (size_t)l * 512 * 1024, 512, 1024, WPA + (size_t)l * 1024 * 512, 0, scr, r, lane); continue; } r -= I_P;
        if (r < I_P) { tr_item(a->in[16] + (size_t)l * 512 * 1024, 512, 1024, WPB + (size_t)l * 1024 * 512, 0, scr, r, lane); continue; } r -= I_P;
        if (r < I_O) { tr_item(a->in[17] + (size_t)l * 1024 * 1024, 1024, 1024, WO + (size_t)l * 1024 * 1024, 0, scr, r, lane); continue; } r -= I_O;
        if (r < 2 * I_W1) { const int w = l * 2 + r / I_W1; tr_item(a->in[9] + (size_t)w * 2048 * 128, 2048, 128, W1T + (size_t)w * 128 * 2048, 0, scr, r % I_W1, lane, 0); continue; } r -= 2 * I_W1;
        {
            const float* pe = a->in[8]; const float* w1 = a->in[9]; float* pecp = (float*)(a->ws + WS_PECP);
            const int lj = l * 2 + (r >> 5), fc = (r >> 4) & 1, kc = r & 15, f = fc * 64 + lane;
            float acc = 0.f;
#pragma unroll 8
            for (int k = kc * 128; k < kc * 128 + 128; ++k) acc += pe[lj * 2048 + k] * w1[((size_t)lj * 2048 + k) * 128 + f];
            pecp[(lj * 16 + kc) * 128 + f] = acc;
        }
    }
}
__device__ __forceinline__ void bg_prep(CArgsP a, LAS unsigned char* lds, int nwg, int half, int G, int bid, int tid, int wave, int lane) {
    const int rem = nwg % G, first_idle = rem, nidle = G - rem;
    if (bid < first_idle) return;
    prep_sc(a, lds, tid);
    const int lo = (LAYER_ITEMS * half) / 3, hi = (LAYER_ITEMS * (half + 1)) / 3;
    prep_items(a, lds, 1, lo, hi, (bid - first_idle) * NWAVES + wave, nidle * NWAVES, wave, lane);
}

__device__ __forceinline__ void phase_prologue(CArgsP a, LAS unsigned char* lds, int tid, int wave, int lane) {
    const int G = gridDim.x, gw = blockIdx.x * NWAVES + wave, NGW = G * NWAVES;
    if (tid == 0) {
        pg8::StaticOrder S; S.init(MROWS, 1024, G, (int)blockIdx.x); pg8::Unit u;
        if (S.next(0, u)) ((unsigned*)(a->ws + WS_XT))[u.pm * 4 + u.pn] = xb_xcc_id() + 1u;
    }
    prep_sc(a, lds, tid);
    prep_items(a, lds, 0, 0, LAYER_ITEMS, gw, NGW, wave, lane);
    if (!BG_PREP) prep_items(a, lds, 1, 0, LAYER_ITEMS, gw, NGW, wave, lane);
    {
        float* rc = (float*)(a->ws + WS_ROPE); float* rs = rc + 65536;
        for (int i = blockIdx.x * NTHR + tid; i < 65536; i += G * NTHR) {
            const int pos = i >> 5, f = i & 31;
            const float inv = exp2f(-(float)f * (13.287712379549449f / 32.f));
            const float angf = (float)pos * inv;
            double t = (double)angf * 0.15915494309189535; t -= floor(t);
            const float tf = (float)t;
            rc[i] = __builtin_amdgcn_cosf(tf); rs[i] = __builtin_amdgcn_sinf(tf);
        }
    }
}

__device__ __forceinline__ void phase_norm(CArgsP a, LAS unsigned char* lds, const float* hin, int l, int sub, int tid, int wave, int lane) {
    LAS float* SH = (LAS float*)lds;
    const float* modp = (const float*)(a->ws + WS_MODP); const float* adab = a->in[3];
    const float* gvec = a->in[4] + (l * 3 + sub) * 1024;
    bf16_t* XN = (bf16_t*)(a->ws + WS_XN);
    for (int blk = blockIdx.x; blk < 256; blk += gridDim.x) {
        const int b = blk >> 5;
        __syncthreads();
        { const int which = tid >> 8, c4 = 4 * (tid & 255);
          f32x4 v = modv4(modp, adab, l, b, (sub * 3 + which) * 1024 + c4);
          if (which) v += 1.f;
          *(LAS f32x4*)(SH + which * 1024 + c4) = v; }
        __syncthreads();
        for (int rr = 0; rr < 8; ++rr) {
            const int row = blk * 64 + wave * 8 + rr;
            const f32x4* xr = (const f32x4*)(hin + (size_t)row * 1024) + lane;
            f32x4 v[4]; float ss = 0.f;
#pragma unroll
            for (int j = 0; j < 4; ++j) { v[j] = xr[64 * j]; ss += (v[j].x * v[j].x + v[j].y * v[j].y) + (v[j].z * v[j].z + v[j].w * v[j].w); }
            const float rstd = rsqrtf(wave_sum(ss) * (1.f / 1024.f) + 1e-6f);
#pragma unroll
            for (int j = 0; j < 4; ++j) {
                const int col = 4 * lane + 256 * j;
                const f32x4 g4 = *(const f32x4*)(gvec + col), sh = *(const LAS f32x4*)(SH + col), sc = *(const LAS f32x4*)(SH + 1024 + col);
                const f32x4 o = (v[j] * rstd) * g4 * sc + sh;
                u32x2 w; w.x = pk2(o.x, o.y); w.y = pk2(o.z, o.w);
                *(u32x2*)(XN + (size_t)row * 1024 + col) = w;
            }
        }
    }
}
__device__ __forceinline__ void phase_final_norm(CArgsP a, int wave, int lane) {
    const float* gvec = a->in[18];
    const int gw = blockIdx.x * NWAVES + wave, NGW = gridDim.x * NWAVES;
    for (int row = gw; row < MROWS; row += NGW) {
        f32x4* xr = (f32x4*)(a->out + (size_t)row * 1024) + lane;
        f32x4 v[4]; float ss = 0.f;
#pragma unroll
        for (int j = 0; j < 4; ++j) { v[j] = xr[64 * j]; ss += (v[j].x * v[j].x + v[j].y * v[j].y) + (v[j].z * v[j].z + v[j].w * v[j].w); }
        const float rstd = rsqrtf(wave_sum(ss) * (1.f / 1024.f) + 1e-6f);
#pragma unroll
        for (int j = 0; j < 4; ++j) { const f32x4 g4 = *(const f32x4*)(gvec + 4 * lane + 256 * j); xr[64 * j] = (v[j] * rstd) * g4; }
    }
}

struct EpiSwiglu {
    static constexpr bool PERM = true, AFTER_DRAIN = false;
    bf16_t* HID;
    __device__ __forceinline__ void operator()(const pg8::f32x4 (&acc)[2][2][4][2], const pg8::Unit& u, int wr, int wc, int fr, int fq) const {
        const int R0 = wr * 64 + fr, hc = u.pn * 128 + wc * 32 + 8 * fq;
        bf16_t* tp = HID + ((size_t)(u.pm * (DFF / 64) + (hc >> 6)) * 256) * 64 + (hc & 63);
#pragma unroll
        for (int ai = 0; ai < 2; ++ai)
#pragma unroll
            for (int m = 0; m < 4; ++m) {
                const pg8::f32x4 x0 = acc[ai][0][m][0], y0 = acc[ai][1][m][0], x1 = acc[ai][0][m][1], y1 = acc[ai][1][m][1];
                u32x4 w;
                w.x = pk2(silu_f(x0[0]) * y0[0], silu_f(x0[1]) * y0[1]); w.y = pk2(silu_f(x0[2]) * y0[2], silu_f(x0[3]) * y0[3]);
                w.z = pk2(silu_f(x1[0]) * y1[0], silu_f(x1[1]) * y1[1]); w.w = pk2(silu_f(x1[2]) * y1[2], silu_f(x1[3]) * y1[3]);
                *(u32x4*)(tp + (size_t)(R0 + ai * 128 + m * 16) * 64) = w;
            }
    }
};
struct EpiResid {
    static constexpr bool PERM = false, AFTER_DRAIN = false;
    const float* hin; float* hout; const float* modp; const float* adab; int l, gidx; float scl;
    __device__ __forceinline__ void operator()(const pg8::f32x4 (&acc)[2][2][4][2], const pg8::Unit& u, int wr, int wc, int fr, int fq) const {
        const int row0 = u.pm * 256 + wr * 64 + fr, b = u.pm >> 3, colb = u.pn * 256 + wc * 32 + 4 * fq;
        f32x4 g4[2][2];
#pragma unroll
        for (int bj = 0; bj < 2; ++bj)
#pragma unroll
            for (int n = 0; n < 2; ++n) g4[bj][n] = modv4(modp, adab, l, b, gidx + colb + bj * 128 + n * 16) * scl;
#pragma unroll
        for (int ai = 0; ai < 2; ++ai)
#pragma unroll
            for (int mh = 0; mh < 2; ++mh) {
                f32x4 hv[2][2][2];
#pragma unroll
                for (int m2 = 0; m2 < 2; ++m2)
#pragma unroll
                    for (int bj = 0; bj < 2; ++bj)
#pragma unroll
                        for (int n = 0; n < 2; ++n) hv[m2][bj][n] = *(const f32x4*)(hin + (size_t)(row0 + ai * 128 + (mh * 2 + m2) * 16) * 1024 + colb + bj * 128 + n * 16);
#pragma unroll
                for (int m2 = 0; m2 < 2; ++m2)
#pragma unroll
                    for (int bj = 0; bj < 2; ++bj)
#pragma unroll
                        for (int n = 0; n < 2; ++n) *(f32x4*)(hout + (size_t)(row0 + ai * 128 + (mh * 2 + m2) * 16) * 1024 + colb + bj * 128 + n * 16) = hv[m2][bj][n] + g4[bj][n] * acc[ai][bj][mh * 2 + m2][n];
            }
    }
};
struct EpiMix {
    static constexpr bool PERM = true, AFTER_DRAIN = false;
    bf16_t *QR, *KV, *EW; float* GATES; const float *rc, *rs;
    __device__ __forceinline__ void operator()(const pg8::f32x4 (&acc)[2][2][4][2], const pg8::Unit& u, int wr, int wc, int fr, int fq) const {
        const int row0 = u.pm * 256 + wr * 64 + fr;
        if (u.pn < 5) {
#pragma unroll
            for (int bj = 0; bj < 2; ++bj) {
                const int blk64 = u.pn * 4 + bj * 2 + (wc >> 1);
                const bool isq = blk64 < 8; const int kvb = blk64 - 8, jkv = kvb >> 1;
                const bool rope = isq || jkv == 2 || jkv == 4;
                const float scl = isq ? QSCALE : 1.f;
                bf16_t* dst = isq ? (QR + blk64 * 64) : (KV + kvb * 64); const int ld = isq ? 512 : 768;
                const int d0 = 16 * (wc & 1) + 4 * fq;
#pragma unroll
                for (int ai = 0; ai < 2; ++ai) {
                    f32x4 csv[4], snv[4];
                    if (rope) {
#pragma unroll
                        for (int m = 0; m < 4; ++m) { const int pos = (row0 + ai * 128 + m * 16) & 2047; csv[m] = *(const f32x4*)(rc + pos * 32 + d0); snv[m] = *(const f32x4*)(rs + pos * 32 + d0); }
                    }
#pragma unroll
                    for (int m = 0; m < 4; ++m) {
                        const int row = row0 + ai * 128 + m * 16;
                        f32x4 v0 = acc[ai][bj][m][0], v1 = acc[ai][bj][m][1];
                        if (rope) {
                            const f32x4 cs = csv[m], sn = snv[m];
                            const f32x4 o0 = v0 * cs - v1 * sn, o1 = v1 * cs + v0 * sn; v0 = o0; v1 = o1;
                        }
                        v0 *= scl; v1 *= scl;
                        u32x2 w0, w1; w0.x = pk2(v0.x, v0.y); w0.y = pk2(v0.z, v0.w); w1.x = pk2(v1.x, v1.y); w1.y = pk2(v1.z, v1.w);
                        bf16_t* rp = dst + (size_t)row * ld + d0;
                        *(u32x2*)rp = w0; *(u32x2*)(rp + 32) = w1;
                    }
                }
            }
        } else if (u.pn < 17) {
            const bool isgelu = u.pn < 9;
#pragma unroll
            for (int bj = 0; bj < 2; ++bj) {
                const int col = (u.pn - 5) * 256 + bj * 128 + wc * 32 + 8 * fq;
#pragma unroll
                for (int ai = 0; ai < 2; ++ai)
#pragma unroll
                    for (int m = 0; m < 4; ++m) {
                        const int row = row0 + ai * 128 + m * 16;
                        u32x4 w;
#pragma unroll
                        for (int n = 0; n < 2; ++n) {
                            const f32x4 v = acc[ai][bj][m][n]; f32x4 o;
                            if (isgelu) { o.x = gelu_tanh_f(v.x); o.y = gelu_tanh_f(v.y); o.z = gelu_tanh_f(v.z); o.w = gelu_tanh_f(v.w); }
                            else { o.x = sigm(v.x); o.y = sigm(v.y); o.z = sigm(v.z); o.w = sigm(v.w); }
                            if (n == 0) { w.x = pk2(o.x, o.y); w.y = pk2(o.z, o.w); } else { w.z = pk2(o.x, o.y); w.w = pk2(o.z, o.w); }
                        }
                        *(u32x4*)(EW + (size_t)row * 3072 + col) = w;
                    }
            }
        } else {
            if (wc == 0) {
#pragma unroll
                for (int n = 0; n < 2; ++n) {
                    const int c = 8 * fq + 4 * n;
                    if (c < 24) {
#pragma unroll
                        for (int ai = 0; ai < 2; ++ai)
#pragma unroll
                            for (int m = 0; m < 4; ++m) {
                                const int row = row0 + ai * 128 + m * 16;
                                const f32x4 v = acc[ai][0][m][n]; f32x4 o; o.x = sigm(v.x); o.y = sigm(v.y); o.z = sigm(v.z); o.w = sigm(v.w);
                                *(f32x4*)(GATES + (size_t)row * 24 + c) = o;
                            }
                    }
                }
            }
        }
    }
};
template <int SECOND> struct EpiProj {
    static constexpr bool PERM = true, AFTER_DRAIN = false;
    const bf16_t* EW; bf16_t* MG;
    __device__ __forceinline__ void operator()(const pg8::f32x4 (&acc)[2][2][4][2], const pg8::Unit& u, int wr, int wc, int fr, int fq) const {
        const int row0 = u.pm * 256 + wr * 64 + fr, colb = u.pn * 256 + wc * 32 + 8 * fq;
#pragma unroll
        for (int ai = 0; ai < 2; ++ai)
#pragma unroll
            for (int mh = 0; mh < 2; ++mh) {
                u32x4 gw[2][2]; unsigned long long pv[2][2][2];
#pragma unroll
                for (int m2 = 0; m2 < 2; ++m2)
#pragma unroll
                    for (int bj = 0; bj < 2; ++bj) {
                        const int row = row0 + ai * 128 + (mh * 2 + m2) * 16, col = colb + bj * 128;
                        gw[m2][bj] = *(const u32x4*)(EW + (size_t)row * 3072 + (SECOND ? 2048 : 1024) + col);
                        if (SECOND) {
                            unsigned long long* mp = (unsigned long long*)(MG + (size_t)row * 1024 + col);
                            pv[m2][bj][0] = __hip_atomic_load(mp, __ATOMIC_RELAXED, __HIP_MEMORY_SCOPE_AGENT);
                            pv[m2][bj][1] = __hip_atomic_load(mp + 1, __ATOMIC_RELAXED, __HIP_MEMORY_SCOPE_AGENT);
                        }
                    }
#pragma unroll
                for (int m2 = 0; m2 < 2; ++m2)
#pragma unroll
                    for (int bj = 0; bj < 2; ++bj) {
                        const int row = row0 + ai * 128 + (mh * 2 + m2) * 16, col = colb + bj * 128;
                        const u32x4 g = gw[m2][bj]; u32x4 w;
#pragma unroll
                        for (int n = 0; n < 2; ++n) {
                            const f32x4 v = acc[ai][bj][mh * 2 + m2][n];
                            const unsigned g0 = n ? g.z : g.x, g1 = n ? g.w : g.y;
                            float o0 = bf_lo(g0) * v.x, o1 = bf_hi(g0) * v.y, o2 = bf_lo(g1) * v.z, o3 = bf_hi(g1) * v.w;
                            if (SECOND) { const unsigned plo = (unsigned)pv[m2][bj][n], phi = (unsigned)(pv[m2][bj][n] >> 32); o0 += bf_lo(plo); o1 += bf_hi(plo); o2 += bf_lo(phi); o3 += bf_hi(phi); }
                            if (n == 0) { w.x = pk2(o0, o1); w.y = pk2(o2, o3); } else { w.z = pk2(o0, o1); w.w = pk2(o2, o3); }
                        }
                        *(u32x4*)(MG + (size_t)row * 1024 + col) = w;
                    }
            }
    }
};

__device__ __forceinline__ void compress_unit(CArgsP a, LAS unsigned char* lds, int l, int u, int tid, int wave, int lane) {
    const int b = u >> 5, g = (u >> 4) & 1, j = (u >> 3) & 1, nb = u & 7;
    LAS float* H = (LAS float*)lds;
    LAS float* OB = H + 16 * 129;
    LAS float* W2s = OB + 16 * 65;
    const bf16_t* KV = (const bf16_t*)(a->ws + WS_KV); const bf16_t* W1T = (const bf16_t*)(a->ws + WS_W1T);
    const float* pecp = (const float*)(a->ws + WS_PECP); const float* w2 = a->in[10] + (size_t)(l * 2 + j) * 128 * 64;
    const float* rc = (const float*)(a->ws + WS_ROPE); const float* rs = rc + 65536;
    const int fr = lane & 15, fq = lane >> 4;
    {
        f32x4 wt[4];
#pragma unroll
        for (int i = 0; i < 4; ++i) wt[i] = *(const f32x4*)(w2 + (i * 512 + tid) * 4);
#pragma unroll
        for (int i = 0; i < 4; ++i) *(LAS f32x4*)(W2s + (i * 512 + tid) * 4) = wt[i];
    }
    {
        const int n = nb * 16 + fr;
        const bf16_t* Ab = KV + (size_t)(b * 2048 + 16 * n) * 768 + (j * 2 + g) * 64;
        const bf16_t* Bb = W1T + (size_t)((l * 2 + j) * 128 + wave * 16 + fr) * 2048;
        f32x4 acc = {0.f, 0.f, 0.f, 0.f};
        bf16x8 a0[4], b0[4], a1[4], b1[4];
#define CMP_LOAD(A_, B_, it_) _Pragma("unroll") for (int i_ = 0; i_ < 4; ++i_) { const int k_ = ((it_) * 4 + i_) * 32 + 8 * fq; A_[i_] = *(const bf16x8*)(Ab + (k_ >> 6) * 768 + (k_ & 63)); B_[i_] = *(const bf16x8*)(Bb + k_); }
#define CMP_MMA(A_, B_) _Pragma("unroll") for (int i_ = 0; i_ < 4; ++i_) acc = __builtin_amdgcn_mfma_f32_16x16x32_bf16(A_[i_], B_[i_], acc, 0, 0, 0);
        CMP_LOAD(a0, b0, 0)
#pragma unroll 1
        for (int it = 0; it < 16; it += 2) {
            CMP_LOAD(a1, b1, it + 1)
            CMP_MMA(a0, b0)
            if (it + 2 < 16) { CMP_LOAD(a0, b0, it + 2) }
            CMP_MMA(a1, b1)
        }
#undef CMP_LOAD
#undef CMP_MMA
#pragma unroll
        for (int r = 0; r < 4; ++r) H[(4 * fq + r) * 129 + wave * 16 + fr] = acc[r];
    }
    __syncthreads();
    {
        const int f = tid & 127; float pec = 0.f;
#pragma unroll
        for (int kc = 0; kc < 16; ++kc) pec += pecp[((l * 2 + j) * 16 + kc) * 128 + f];
#pragma unroll
        for (int i = 0; i < 4; ++i) { const int n = (tid >> 7) + 4 * i; H[n * 129 + f] = silu_f(H[n * 129 + f] + pec); }
    }
    __syncthreads();
    const int n = tid >> 5, d2 = (tid & 31) * 2;
    float o0 = 0.f, o1 = 0.f;
#pragma unroll 8
    for (int f = 0; f < 128; ++f) { const float hv = H[n * 129 + f]; const float w0 = W2s[f * 64 + d2], w1 = W2s[f * 64 + d2 + 1]; o0 += hv * w0; o1 += hv * w1; }
    const int ng = nb * 16 + n;
    if (j == 0) {
        OB[n * 65 + d2] = o0; OB[n * 65 + d2 + 1] = o1;
        __syncthreads();
        const int pos = 16 * ng + 31, dd = d2 & 31;
        const float c0 = rc[pos * 32 + dd], c1 = rc[pos * 32 + dd + 1], s0 = rs[pos * 32 + dd], s1 = rs[pos * 32 + dd + 1];
        const int od = d2 < 32 ? d2 + 32 : d2 - 32;
        const float p0 = OB[n * 65 + od], p1 = OB[n * 65 + od + 1];
        if (d2 < 32) { o0 = o0 * c0 - p0 * s0; o1 = o1 * c1 - p1 * s1; } else { o0 = o0 * c0 + p0 * s0; o1 = o1 * c1 + p1 * s1; }
    }
    if (ng == 127) { o0 = 0.f; o1 = 0.f; }
    bf16_t* dst = (bf16_t*)(a->ws + (j ? WS_VC : WS_KC)) + (size_t)((b * 2 + g) * 128 + ng) * 64 + d2;
    *(unsigned*)dst = pk2(o0, o1);
    __syncthreads();
}

__device__ __forceinline__ void gmlp_unit(CArgsP a, LAS unsigned char* lds, int l, int u, int tid, int wave, int lane) {
    const int b = u >> 5, ch = (u >> 1) & 15, h2 = u & 1;
    const int R0 = b * 2048 + ch * 128;
    const bf16_t* EW = (const bf16_t*)(a->ws + WS_EW); bf16_t* YB = (bf16_t*)(a->ws + WS_YB);
    const float* lng = a->in[11] + l * 512; const float* lnb = a->in[12] + l * 512;
    const float* gws = a->in[13] + (size_t)l * 8 * 128 * 128; const float* gbs = a->in[14] + l * 8 * 128;
    LAS unsigned char* VN = lds;
    {
        const f32x4 g0 = *(const f32x4*)(lng + 8 * lane), g1 = *(const f32x4*)(lng + 8 * lane + 4);
        const f32x4 b0 = *(const f32x4*)(lnb + 8 * lane), b1 = *(const f32x4*)(lnb + 8 * lane + 4);
#pragma unroll 1
        for (int rb = 0; rb < 2; ++rb) {
        u32x4 raw[8];
#pragma unroll
        for (int rr = 0; rr < 8; ++rr) raw[rr] = *(const u32x4*)(EW + (size_t)(R0 + wave * 16 + rb * 8 + rr) * 3072 + 512 + 8 * lane);
#pragma unroll
        for (int rr = 0; rr < 8; ++rr) {
            const int srow = wave * 16 + rb * 8 + rr;
            float x[8] = {bf_lo(raw[rr].x), bf_hi(raw[rr].x), bf_lo(raw[rr].y), bf_hi(raw[rr].y), bf_lo(raw[rr].z), bf_hi(raw[rr].z), bf_lo(raw[rr].w), bf_hi(raw[rr].w)};
            float s = 0.f;
#pragma unroll
            for (int i = 0; i < 8; ++i) s += x[i];
            const float mu = wave_sum(s) * (1.f / 512.f);
            float qv = 0.f;
#pragma unroll
            for (int i = 0; i < 8; ++i) { x[i] -= mu; qv += x[i] * x[i]; }
            const float rstd = rsqrtf(wave_sum(qv) * (1.f / 512.f) + 1e-6f);
            u32x4 o;
            o.x = pk2(x[0] * rstd * g0.x + b0.x, x[1] * rstd * g0.y + b0.y); o.y = pk2(x[2] * rstd * g0.z + b0.z, x[3] * rstd * g0.w + b0.w);
            o.z = pk2(x[4] * rstd * g1.x + b1.x, x[5] * rstd * g1.y + b1.y); o.w = pk2(x[6] * rstd * g1.z + b1.z, x[7] * rstd * g1.w + b1.w);
            if ((lane >> 5) == h2) *(LAS u32x4*)(VN + srow * 576 + (lane & 31) * 16) = o;
        }
        }
    }
    __syncthreads();
    const int tb = wave >> 1, cb = wave & 1, q = lane & 31, hi = lane >> 5, blk = (lane >> 4) & 1, qq = (lane & 15) >> 2, p = lane & 3;
    const int t = 32 * tb + q, kmax = 2 * tb + 1;
    for (int gl = 0; gl < 4; ++gl) {
        const int g = h2 * 4 + gl;
        const float* wrow = gws + ((size_t)g * 128 + t) * 128;
        const int c = 64 * g + 32 * cb + q;
        f32x4 wa[8], wb[8];
#pragma unroll
        for (int ks = 0; ks < 8; ++ks) if (ks <= kmax) { wa[ks] = *(const f32x4*)(wrow + 16 * ks + 8 * hi); wb[ks] = *(const f32x4*)(wrow + 16 * ks + 8 * hi + 4); }
        const int trow = R0 + t; const float bsv = gbs[g * 128 + t];
        u32x2 ur[4];
#pragma unroll
        for (int rr = 0; rr < 4; ++rr) ur[rr] = *(const u32x2*)(EW + (size_t)trow * 3072 + 64 * g + 32 * cb + 8 * rr + 4 * hi);
        f32x16 acc;
#pragma unroll
        for (int i = 0; i < 16; ++i) acc[i] = 0.f;
#pragma unroll
        for (int ks = 0; ks < 8; ++ks) if (ks <= kmax) {
            const int s0 = 16 * ks + 8 * hi;
            const f32x4 w0 = wa[ks], w1 = wb[ks];
            u32x4 ap;
            ap.x = pk2(s0 + 0 <= t ? w0.x : 0.f, s0 + 1 <= t ? w0.y : 0.f); ap.y = pk2(s0 + 2 <= t ? w0.z : 0.f, s0 + 3 <= t ? w0.w : 0.f);
            ap.z = pk2(s0 + 4 <= t ? w1.x : 0.f, s0 + 5 <= t ? w1.y : 0.f); ap.w = pk2(s0 + 6 <= t ? w1.z : 0.f, s0 + 7 <= t ? w1.w : 0.f);
            LAS unsigned char* vp = VN + (16 * ks + 8 * hi + qq) * 576 + (64 * gl + 32 * cb + 16 * blk + 4 * p) * 2;
            const s16x4 lo = tr_read(vp), hi4 = tr_read(vp + 4 * 576);
            acc = MFMA32(cat8(lo, hi4), __builtin_bit_cast(bf16x8, ap), acc);
        }
#pragma unroll
        for (int rr = 0; rr < 4; ++rr) {
            const float y0 = bf_lo(ur[rr].x) * (acc[4 * rr + 0] + bsv), y1 = bf_hi(ur[rr].x) * (acc[4 * rr + 1] + bsv);
            const float y2 = bf_lo(ur[rr].y) * (acc[4 * rr + 2] + bsv), y3 = bf_hi(ur[rr].y) * (acc[4 * rr + 3] + bsv);
            u32x2 w; w.x = pk2(y0, y1); w.y = pk2(y2, y3);
            *(u32x2*)(YB + (size_t)trow * 512 + 64 * g + 32 * cb + 8 * rr + 4 * hi) = w;
        }
    }
    __syncthreads();
}

constexpr int AT_BUF2 = 107520;
constexpr int AT_KT = 0, AT_VT = 9216, AT_KC = 21504, AT_VC = 39936, AT_IMP4 = 64512, AT_IMPF = AT_IMP4 + 33792, AT_SELM = AT_IMPF + 8448;

template <int MODE>
__device__ __forceinline__ void attn_tile(LAS unsigned char* KT, LAS unsigned char* VT, const bf16x8 (&qf)[4], float& m, float& lsum, f32x16 (&O)[2], int lane, int srel, bool mine, bool needmask) {
    const int q = lane & 31, hi = lane >> 5, blk = (lane >> 4) & 1, qq = (lane & 15) >> 2, p = lane & 3;
    f32x16 S0, S1;
#pragma unroll
    for (int i = 0; i < 16; ++i) { S0[i] = 0.f; S1[i] = 0.f; }
#pragma unroll
    for (int c = 0; c < 4; ++c) {
        const bf16x8 k0 = *(const LAS bf16x8*)(KT + q * 144 + (16 * c + 8 * hi) * 2);
        const bf16x8 k1 = *(const LAS bf16x8*)(KT + (32 + q) * 144 + (16 * c + 8 * hi) * 2);
        S0 = MFMA32(k0, qf[c], S0); S1 = MFMA32(k1, qf[c], S1);
    }
    if (needmask) {
#pragma unroll
        for (int r = 0; r < 16; ++r) {
            const int kk = crow(r, hi);
            bool v0, v1;
            if (MODE == 1) { v0 = mine && (kk <= srel); v1 = mine && (kk + 32 <= srel); }
            else { v0 = (kk <= srel) && (kk > srel - 512); v1 = (kk + 32 <= srel) && (kk + 32 > srel - 512); }
            S0[r] = v0 ? S0[r] : -1e30f; S1[r] = v1 ? S1[r] : -1e30f;
        }
    }
    float mx = fmaxf(S0[0], S1[0]);
#pragma unroll
    for (int r = 1; r < 16; ++r) mx = fmaxf(mx, fmaxf(S0[r], S1[r]));
    mx = fmaxf(mx, __shfl_xor(mx, 32));
    if (__ballot(mx > m + 6.f) != 0ull) {
        const float mnew = fmaxf(m, mx), alpha = fexp2(m - mnew);
        m = mnew; lsum *= alpha;
#pragma unroll
        for (int i = 0; i < 16; ++i) { O[0][i] *= alpha; O[1][i] *= alpha; }
    }
    float rs = 0.f;
#pragma unroll
    for (int r = 0; r < 16; ++r) { S0[r] = fexp2(S0[r] - m); S1[r] = fexp2(S1[r] - m); rs += S0[r] + S1[r]; }
    rs += __shfl_xor(rs, 32);
    lsum += rs;
#pragma unroll
    for (int sp = 0; sp < 2; ++sp) {
        const bf16x8 p0 = PACK8(S0, sp), p1 = PACK8(S1, sp);
#pragma unroll
        for (int dh = 0; dh < 2; ++dh) {
            LAS unsigned char* vp0 = VT + (16 * sp + 4 * hi + qq) * 192 + (32 * dh + 16 * blk + 4 * p) * 2;
            const bf16x8 vf0 = cat8(tr_read(vp0), tr_read(vp0 + 8 * 192));
            O[dh] = MFMA32(vf0, p0, O[dh]);
            LAS unsigned char* vp1 = vp0 + 32 * 192;
            const bf16x8 vf1 = cat8(tr_read(vp1), tr_read(vp1 + 8 * 192));
            O[dh] = MFMA32(vf1, p1, O[dh]);
        }
    }
}

__device__ __forceinline__ void attn_load(u32x4& kv, u32x4& vv, const bf16_t* base, int kcol, int vcol, int tid) {
    const unsigned loff = (unsigned)((tid >> 3) * 768 + 8 * (tid & 7)) * 2u;
    kv = *(const u32x4*)((const char*)(base + kcol) + loff);
    vv = *(const u32x4*)((const char*)(base + vcol) + loff);
}
__device__ __forceinline__ void attn_store(LAS unsigned char* KT, LAS unsigned char* VT, const u32x4& kv, const u32x4& vv, int tid) {
    const int key = tid >> 3, chk = tid & 7;
    *(LAS u32x4*)(KT + key * 144 + chk * 16) = kv;
    *(LAS u32x4*)(VT + key * 192 + chk * 16) = vv;
}

__device__ __forceinline__ int next_tile(unsigned& rem) { if (!rem) return -1; const int j = __builtin_ctz(rem); rem &= rem - 1u; return j; }
template <int MODE>
__device__ __forceinline__ void attn_pass(LAS unsigned char* lds, const bf16_t* KVb, int kcol, int vcol, unsigned rem, unsigned mysel, int qt, int s,
                                          const bf16x8 (&qf)[4], float& m, float& lsum, f32x16 (&O)[2], int tid, int lane) {
    u32x4 ak, av, bk, bv;
    int j = next_tile(rem), j1 = next_tile(rem), j2 = next_tile(rem);
    attn_load(ak, av, KVb + (size_t)(64 * j) * 768, kcol, vcol, tid);
    if (j1 >= 0) attn_load(bk, bv, KVb + (size_t)(64 * j1) * 768, kcol, vcol, tid);
    __syncthreads();
    attn_store(lds + AT_KT, lds + AT_VT, ak, av, tid);
    if (j2 >= 0) attn_load(ak, av, KVb + (size_t)(64 * j2) * 768, kcol, vcol, tid);
#define ATT_STEP(CB, NB, RK, RV) { \
        __syncthreads();                   \
        const int j3 = next_tile(rem); \
        if (j1 >= 0) { attn_store(lds + (NB), lds + (NB) + 9216, RK, RV, tid); if (j3 >= 0) attn_load(RK, RV, KVb + (size_t)(64 * j3) * 768, kcol, vcol, tid); } \
        if (MODE == 1) { const bool mine = (mysel >> j) & 1u; const unsigned long long bm = __ballot(mine); \
            if (bm != 0ull) attn_tile<1>(lds + (CB), lds + (CB) + 9216, qf, m, lsum, O, lane, s - 64 * j, mine, (bm != ~0ull) || (j == qt)); } \
        else attn_tile<2>(lds + (CB), lds + (CB) + 9216, qf, m, lsum, O, lane, s - 64 * j, true, (j == qt) || (j == qt - 8)); \
        if (j1 < 0) break; \
        j = j1; j1 = j2; j2 = j3; }
    for (;;) {
        ATT_STEP(AT_KT, AT_BUF2, bk, bv)
        ATT_STEP(AT_BUF2, AT_KT, ak, av)
    }
#undef ATT_STEP
}

__device__ __forceinline__ void attn_unit(CArgsP a, LAS unsigned char* lds, int b, int g, int qt, int tid, int wave, int lane) {
    LAS unsigned char* KT = lds + AT_KT; LAS unsigned char* VT = lds + AT_VT; LAS unsigned char* KCs = lds + AT_KC; LAS unsigned char* VCs = lds + AT_VC;
    LAS float* IMP4 = (LAS float*)(lds + AT_IMP4); LAS float* IMPF = (LAS float*)(lds + AT_IMPF); LAS unsigned* SELM = (LAS unsigned*)(lds + AT_SELM);
    const bf16_t* QR = (const bf16_t*)(a->ws + WS_QR); const bf16_t* KV = (const bf16_t*)(a->ws + WS_KV);
    const bf16_t* KCg = (const bf16_t*)(a->ws + WS_KC) + (size_t)(b * 2 + g) * 128 * 64; const bf16_t* VCg = (const bf16_t*)(a->ws + WS_VC) + (size_t)(b * 2 + g) * 128 * 64;
    const float* GATES = (const float*)(a->ws + WS_GATES); bf16_t* YA = (bf16_t*)(a->ws + WS_YA);
    const int hh = wave >> 1, qh = wave & 1, q = lane & 31, hi = lane >> 5, blk = (lane >> 4) & 1, qq = (lane & 15) >> 2, p = lane & 3;
    const int s = qt * 64 + qh * 32 + q, head = g * 4 + hh;
    const int row = b * 2048 + s;
#pragma unroll
    for (int i = 0; i < 2; ++i) {
        const int idx = tid + 512 * i, r = idx >> 3, c = idx & 7;
        *(LAS u32x4*)(KCs + r * 144 + c * 16) = *(const u32x4*)(KCg + r * 64 + c * 8);
        *(LAS u32x4*)(VCs + r * 192 + c * 16) = *(const u32x4*)(VCg + r * 64 + c * 8);
    }
    bf16x8 qf[4];
#pragma unroll
    for (int c = 0; c < 4; ++c) qf[c] = *(const bf16x8*)(QR + (size_t)row * 512 + head * 64 + 16 * c + 8 * hi);
    __syncthreads();
    f32x16 oacc[2];
    {
        f32x16 S[4];
#pragma unroll
        for (int kb = 0; kb < 4; ++kb) {
#pragma unroll
            for (int i = 0; i < 16; ++i) S[kb][i] = 0.f;
#pragma unroll
            for (int c = 0; c < 4; ++c) { const bf16x8 kf = *(const LAS bf16x8*)(KCs + (32 * kb + q) * 144 + (16 * c + 8 * hi) * 2); S[kb] = MFMA32(kf, qf[c], S[kb]); }
        }
        const int nlim = (s - 31) >> 4;
        float mx = -1e30f;
#pragma unroll
        for (int kb = 0; kb < 4; ++kb)
#pragma unroll
            for (int r = 0; r < 16; ++r) { const int n = 32 * kb + crow(r, hi); S[kb][r] = (n <= nlim) ? S[kb][r] : -1e30f; mx = fmaxf(mx, S[kb][r]); }
        mx = fmaxf(mx, __shfl_xor(mx, 32));
        float sum = 0.f;
#pragma unroll
        for (int kb = 0; kb < 4; ++kb)
#pragma unroll
            for (int r = 0; r < 16; ++r) { S[kb][r] = fexp2(S[kb][r] - mx); sum += S[kb][r]; }
        sum += __shfl_xor(sum, 32);
        const float inv = (s >= 31) ? 1.f / sum : 0.f;
        float prevX = 0.f;
        LAS float* impw = IMP4 + (hh * 64 + qh * 32 + q) * 33;
#pragma unroll
        for (int kb = 0; kb < 4; ++kb) {
#pragma unroll
            for (int r = 0; r < 16; ++r) S[kb][r] *= inv;
#pragma unroll
            for (int rr = 0; rr < 4; ++rr) {
                const float E = 0.5f * S[kb][4 * rr + 3];
                const float T = S[kb][4 * rr] + S[kb][4 * rr + 1] + S[kb][4 * rr + 2] + E;
                const float X = __shfl_xor(E, 32);
                impw[8 * kb + 2 * rr + hi] = T + (hi ? X : prevX);
                prevX = X;
            }
        }
        f32x16 O[2];
#pragma unroll
        for (int i = 0; i < 16; ++i) { O[0][i] = 0.f; O[1][i] = 0.f; }
#pragma unroll
        for (int kb = 0; kb < 4; ++kb)
#pragma unroll
            for (int sp = 0; sp < 2; ++sp) {
                const bf16x8 pf = PACK8(S[kb], sp);
#pragma unroll
                for (int dh = 0; dh < 2; ++dh) {
                    LAS unsigned char* vp = VCs + (32 * kb + 16 * sp + 4 * hi + qq) * 192 + (32 * dh + 16 * blk + 4 * p) * 2;
                    const bf16x8 vf = cat8(tr_read(vp), tr_read(vp + 8 * 192));
                    O[dh] = MFMA32(vf, pf, O[dh]);
                }
            }
        const float g0 = GATES[(size_t)row * 24 + head * 3 + 0];
#pragma unroll
        for (int i = 0; i < 16; ++i) { oacc[0][i] = g0 * O[0][i]; oacc[1][i] = g0 * O[1][i]; }
    }
    __syncthreads();
    {
        const int qi = tid >> 3, jb = tid & 7;
        float v[4];
#pragma unroll
        for (int jj = 0; jj < 4; ++jj) {
            const int j = 4 * jb + jj;
            float t = IMP4[(0 * 64 + qi) * 33 + j] + IMP4[(1 * 64 + qi) * 33 + j] + IMP4[(2 * 64 + qi) * 33 + j] + IMP4[(3 * 64 + qi) * 33 + j];
            const bool forced = (j == 0) || (j == qt) || (j == qt - 1), valid = j <= qt;
            t = forced ? 1e4f : (valid ? t : -1e4f);
            v[jj] = t; IMPF[qi * 33 + j] = t;
        }
        __syncthreads();
        unsigned bits = 0u;
#pragma unroll
        for (int jj = 0; jj < 4; ++jj) {
            const int j = 4 * jb + jj; int cnt = 0;
            for (int k = 0; k < 32; ++k) { const float w = IMPF[qi * 33 + k]; cnt += (w > v[jj] || (w == v[jj] && k < j)) ? 1 : 0; }
            bits |= (cnt < 16 ? 1u : 0u) << j;
        }
        bits |= __shfl_xor(bits, 1); bits |= __shfl_xor(bits, 2); bits |= __shfl_xor(bits, 4);
        if (jb == 0) SELM[qi] = bits;
        __syncthreads();
        if (tid < 64) {
            unsigned un = SELM[tid];
#pragma unroll
            for (int o = 1; o < 64; o <<= 1) un |= __shfl_xor(un, o);
            if (tid == 0) SELM[64] = un;
        }
        __syncthreads();
    }
    const unsigned mysel = SELM[qh * 32 + q], uni = SELM[64];
    const bf16_t* KVb = KV + (size_t)b * 2048 * 768;
    LAS float* stash = (LAS float*)(lds + AT_KC + wave * 8192) + lane;
#pragma unroll
    for (int i = 0; i < 16; ++i) { stash[i * 64] = oacc[0][i]; stash[(16 + i) * 64] = oacc[1][i]; }
    {
        float m = 0.f, lsum = 0.f; f32x16 O[2];
#pragma unroll
        for (int i = 0; i < 16; ++i) { O[0][i] = 0.f; O[1][i] = 0.f; }
        const unsigned rem = uni & (qt == 31 ? 0xffffffffu : ((2u << qt) - 1u));
        attn_pass<1>(lds, KVb, (4 + g) * 64, (6 + g) * 64, rem, mysel, qt, s, qf, m, lsum, O, tid, lane);
        const float sc = GATES[(size_t)row * 24 + head * 3 + 1] / lsum;
#pragma unroll
        for (int i = 0; i < 16; ++i) { stash[i * 64] += sc * O[0][i]; stash[(16 + i) * 64] += sc * O[1][i]; }
    }
    {
        float m = 0.f, lsum = 0.f; f32x16 O[2];
#pragma unroll
        for (int i = 0; i < 16; ++i) { O[0][i] = 0.f; O[1][i] = 0.f; }
        const unsigned all = (qt == 31 ? 0xffffffffu : ((2u << qt) - 1u)), lo = (qt > 8) ? ((1u << (qt - 8)) - 1u) : 0u;
        attn_pass<2>(lds, KVb, (8 + g) * 64, (10 + g) * 64, all & ~lo, 0u, qt, s, qf, m, lsum, O, tid, lane);
        const float sc = GATES[(size_t)row * 24 + head * 3 + 2] / lsum;
#pragma unroll
        for (int i = 0; i < 16; ++i) { oacc[0][i] = stash[i * 64] + sc * O[0][i]; oacc[1][i] = stash[(16 + i) * 64] + sc * O[1][i]; }
    }
#pragma unroll
    for (int dh = 0; dh < 2; ++dh)
#pragma unroll
        for (int rr = 0; rr < 4; ++rr) {
            u32x2 w; w.x = pk2(oacc[dh][4 * rr], oacc[dh][4 * rr + 1]); w.y = pk2(oacc[dh][4 * rr + 2], oacc[dh][4 * rr + 3]);
            *(u32x2*)(YA + (size_t)row * 512 + head * 64 + 32 * dh + 8 * rr + 4 * hi) = w;
        }
    __syncthreads();
}

struct PanelNormOrder : pg8::StaticOrder {
    unsigned* cnt; const unsigned* xtab; LAS unsigned char* lds; const float* h; float* fout; bf16_t* XN; const float* modp; const float* adab; const float* gvec; int l, i, fin, tid;
    __device__ __forceinline__ void done(const pg8::Unit& u) const {
        const int wave = __builtin_amdgcn_readfirstlane(tid >> 6), lane = tid & 63;
        LAS float* SH = (LAS float*)(lds + 131072 + 1024);
        asm volatile("s_waitcnt vmcnt(0)" ::: "memory");
        __syncthreads();
        if (tid == 0) {
            const unsigned* xt = xtab + u.pm * 4; const unsigned my = xb_xcc_id() + 1u;
            const bool same_l2 = (xt[0] == my) & (xt[1] == my) & (xt[2] == my) & (xt[3] == my);
            if (!same_l2) { __builtin_amdgcn_fence(__ATOMIC_RELEASE, "agent"); asm volatile("s_waitcnt vmcnt(0)" ::: "memory"); }
            unsigned* c = cnt + 16 * u.pm;
            __hip_atomic_fetch_add(c, 1u, __ATOMIC_RELAXED, __HIP_MEMORY_SCOPE_AGENT);
            unsigned sp = 0;
            while (__hip_atomic_load(c, __ATOMIC_RELAXED, __HIP_MEMORY_SCOPE_AGENT) < 4u) { __builtin_amdgcn_s_sleep(1); if (++sp > (1u << 22)) break; }
            __builtin_amdgcn_fence(__ATOMIC_ACQUIRE, "agent");
            asm volatile("s_waitcnt vmcnt(0)" ::: "memory");
        }
        __syncthreads();
        const int b = u.pm >> 3, r0 = u.pm * 256 + u.pn * 64;
        if (!fin) {
            const int which = tid >> 8, c4 = 4 * (tid & 255);
            f32x4 v = modv4(modp, adab, l, b, (i * 3 + which) * 1024 + c4);
            if (which) v += 1.f;
            *(LAS f32x4*)(SH + which * 1024 + c4) = v;
            __syncthreads();
        }
        for (int rb = 0; rb < 2; ++rb) {
            f32x4 v[4][4];
#pragma unroll
            for (int r4 = 0; r4 < 4; ++r4) {
                const f32x4* xr = (const f32x4*)(h + (size_t)(r0 + wave * 8 + rb * 4 + r4) * 1024) + lane;
#pragma unroll
                for (int j = 0; j < 4; ++j) v[r4][j] = xr[64 * j];
            }
#pragma unroll
            for (int r4 = 0; r4 < 4; ++r4) {
                const int row = r0 + wave * 8 + rb * 4 + r4;
                float ss = 0.f;
#pragma unroll
                for (int j = 0; j < 4; ++j) ss += (v[r4][j].x * v[r4][j].x + v[r4][j].y * v[r4][j].y) + (v[r4][j].z * v[r4][j].z + v[r4][j].w * v[r4][j].w);
                const float rstd = rsqrtf(wave_sum(ss) * (1.f / 1024.f) + 1e-6f);
#pragma unroll
                for (int j = 0; j < 4; ++j) {
                    const int col = 4 * lane + 256 * j;
                    const f32x4 g4 = *(const f32x4*)(gvec + col);
                    if (fin) { *((f32x4*)(fout + (size_t)row * 1024) + lane + 64 * j) = (v[r4][j] * rstd) * g4; }
                    else {
                        const f32x4 sh = *(const LAS f32x4*)(SH + col), sc = *(const LAS f32x4*)(SH + 1024 + col);
                        const f32x4 o = (v[r4][j] * rstd) * g4 * sc + sh;
                        u32x2 w; w.x = pk2(o.x, o.y); w.y = pk2(o.z, o.w);
                        *(u32x2*)(XN + (size_t)row * 1024 + col) = w;
                    }
                }
            }
        }
    }
};

#define XB_TMO      128
#define XB_XCNT(j)  (256  + 64 * (j))
#define XB_XSUB(j)  (1280 + 64 * (j))
#define XB_XGEN(j)  (2304 + 64 * (j))
#define XB_TOP      3328
#define XB_TOPGEN   3392
#define XCD_BAR_WORDS 3456
#define XB_SPIN_CAP (1u << 18)

__device__ __forceinline__ unsigned xb_ld(unsigned* p)              { return __hip_atomic_load(p, __ATOMIC_RELAXED, __HIP_MEMORY_SCOPE_AGENT); }
__device__ __forceinline__ unsigned xb_add(unsigned* p, unsigned v) { return __hip_atomic_fetch_add(p, v, __ATOMIC_RELAXED, __HIP_MEMORY_SCOPE_AGENT); }
__device__ __forceinline__ unsigned xb_xcc_id() { return (unsigned)__builtin_amdgcn_s_getreg((3 << 11) | 20) & 0xFu; }
#define XB_SPIN(cond, bar) do { unsigned _sp = 0; while (cond) { __builtin_amdgcn_s_sleep(1); \
    if ((++_sp & 255u) == 0u) { if (xb_ld(&(bar)[XB_TMO])) break; if (_sp > XB_SPIN_CAP) { atomicAdd(&(bar)[XB_TMO], 1u); break; } } } } while (0)

struct XcdBarrier {
    unsigned* bar; unsigned x;
    volatile LAS unsigned* st;
};

__device__ __forceinline__ XcdBarrier xcd_barrier_post(unsigned* bar, volatile LAS unsigned* st) {
    XcdBarrier b; b.bar = bar; b.x = xb_xcc_id(); b.st = st;
    if (threadIdx.x == 0) (void)xb_add(&bar[XB_XCNT(b.x)], 1u);
    return b;
}
__device__ __forceinline__ void xcd_barrier_complete(unsigned* bar, unsigned x, unsigned& nloc, unsigned& nx) {
    const unsigned G = gridDim.x * gridDim.y * gridDim.z;
    unsigned sum, cnt, mine, sp = 0u;
    for (;;) {
        sum = 0u; cnt = 0u; mine = 0u;
#pragma unroll
        for (unsigned j = 0; j < 16; ++j) { const unsigned c = xb_ld(&bar[XB_XCNT(j)]); sum += c; cnt += (c > 0u) ? 1u : 0u; mine = (j == x) ? c : mine; }
        if (sum == G) break;
        __builtin_amdgcn_s_sleep(1);
        if ((++sp & 255u) == 0u) { if (xb_ld(&bar[XB_TMO])) break; if (sp > XB_SPIN_CAP) { atomicAdd(&bar[XB_TMO], 1u); break; } }
    }
    nloc = mine > 0u ? mine : 1u; nx = cnt > 0u ? cnt : 1u;
}

__device__ __forceinline__ void xcd_barrier(const XcdBarrier& b) {
    asm volatile("s_waitcnt vmcnt(0)" ::: "memory");
    __syncthreads();
    if (threadIdx.x == 0) {
        unsigned* bar = b.bar;
        __builtin_amdgcn_s_waitcnt(0);
        unsigned nloc = b.st[0], nx = b.st[1];
        if (nloc == 0u) { xcd_barrier_complete(bar, b.x, nloc, nx); b.st[0] = nloc; b.st[1] = nx; }
        const unsigned old = xb_add(&bar[XB_XSUB(b.x)], 1u);
        const unsigned gen = old / nloc;
        if (old + 1u == (gen + 1u) * nloc) {
            __builtin_amdgcn_fence(__ATOMIC_RELEASE, "agent");
            asm volatile("s_waitcnt vmcnt(0)" ::: "memory");
            const unsigned og = xb_add(&bar[XB_TOP], 1u);
            const unsigned tg = og / nx;
            if (og + 1u == (tg + 1u) * nx) xb_add(&bar[XB_TOPGEN], 1u);
            else XB_SPIN(xb_ld(&bar[XB_TOPGEN]) == tg, bar);
            __builtin_amdgcn_fence(__ATOMIC_ACQUIRE, "agent");
            xb_add(&bar[XB_XGEN(b.x)], 1u);
            asm volatile("s_waitcnt vmcnt(0)" ::: "memory");
        } else {
            XB_SPIN(xb_ld(&bar[XB_XGEN(b.x)]) == gen, bar);
            __builtin_amdgcn_fence(__ATOMIC_ACQUIRE, "agent");
            asm volatile("s_waitcnt vmcnt(0)" ::: "memory");
        }
    }
    __syncthreads();
}

#define GRID_BAR() do { XcdBarrier xb_; xb_.bar = (unsigned*)(a->ws + WS_BAR); xb_.x = xb_xcc_id(); xb_.st = (volatile LAS unsigned*)(lds + 131072 + 256); xcd_barrier(xb_); } while (0)
template <int ph> __device__ __forceinline__ void phase_work(LAS unsigned char* lds, const int wave_in) {
        CArgsP a = (CArgsP)__builtin_amdgcn_kernarg_segment_ptr();
        int wave = wave_in, G = gridDim.x, bid = blockIdx.x;
        asm volatile("" : "+s"(a), "+s"(wave), "+s"(G), "+s"(bid));
        int lane = __builtin_amdgcn_mbcnt_hi(~0u, __builtin_amdgcn_mbcnt_lo(~0u, 0u));
        asm volatile("" : "+v"(lane));
        const int tid = wave * 64 + lane;
        if constexpr (ph == 0) { if (EN & 1) phase_prologue(a, lds, tid, wave, lane); }
        else if constexpr (ph == N_PHASES - 1) phase_final_norm(a, wave, lane);
        else {
            constexpr int l = (ph - 1) / 12, sub = (ph - 1) % 12;
            const float* hcur = (l == 0 && sub <= 2) ? a->in[0] : a->out;
            const float* modp = (const float*)(a->ws + WS_MODP); const float* adab = a->in[3];
            if constexpr ((EN & 2) && (sub == 0 || sub == 3 || sub == 9)) {
                phase_norm(a, lds, hcur, l, sub == 0 ? 0 : (sub == 3 ? 1 : 2), tid, wave, lane);
            } else if constexpr ((EN & 4) && (sub == 1 || sub == 10)) {
                const int w = l * 2 + (sub == 10 ? 1 : 0);
                pg8::Gemm gm{(const pg8::bf16_t*)(a->ws + WS_XN), (const pg8::bf16_t*)(a->ws + WS_WFI) + (size_t)w * NFF2 * 1024, MROWS, NFF2, 1024, 0, 1};
                pg8::StaticOrder S; S.init(MROWS, NFF2, G, bid);
                EpiSwiglu E{(bf16_t*)(a->ws + WS_HID)};
                pg8::gemm_phase<EpiSwiglu, pg8::StaticOrder, true, true>(lds, gm, S, E, tid);
                if constexpr (BG_PREP && l == 0) bg_prep(a, lds, (MROWS / 256) * (NFF2 / 256), sub == 1 ? 0 : 2, G, bid, tid, wave, lane);
            } else if constexpr ((EN & 8) && (sub == 2 || sub == 11)) {
                const int w = l * 2 + (sub == 11 ? 1 : 0);
                pg8::Gemm gm{(const pg8::bf16_t*)(a->ws + WS_HID), (const pg8::bf16_t*)(a->ws + WS_WFO) + (size_t)w * 1024 * DFF, MROWS, 1024, DFF, 1, 1};
                EpiResid E{hcur, a->out, modp, adab, l, (sub == 2 ? 2 : 8) * 1024, 0.5f};
                if constexpr (FUSE_NORM) {
                    const int fin = (sub == 11 && l == 1) ? 1 : 0, nl = (sub == 11) ? l + 1 : l, ni = (sub == 2) ? 1 : 0;
                    PanelNormOrder S; S.init(MROWS, 1024, G, bid);
                    S.cnt = (unsigned*)(a->ws + WS_CNT) + (l * 3 + (sub == 2 ? 0 : 2)) * 1024; S.xtab = (const unsigned*)(a->ws + WS_XT); S.lds = lds; S.h = a->out; S.fout = a->out; S.XN = (bf16_t*)(a->ws + WS_XN);
                    S.modp = modp; S.adab = adab; S.gvec = fin ? a->in[18] : a->in[4] + (nl * 3 + ni) * 1024; S.l = nl; S.i = ni; S.fin = fin; S.tid = tid;
                    pg8::gemm_phase<EpiResid, PanelNormOrder, true, true>(lds, gm, S, E, tid);
                } else {
                    pg8::StaticOrder S; S.init(MROWS, 1024, G, bid);
                    pg8::gemm_phase<EpiResid, pg8::StaticOrder, true, true>(lds, gm, S, E, tid);
                }
            } else if constexpr ((EN & 16) && sub == 4) {
                pg8::Gemm gm{(const pg8::bf16_t*)(a->ws + WS_XN), (const pg8::bf16_t*)(a->ws + WS_WMIX) + (size_t)l * NINP * 1024, MROWS, NINP, 1024, 0, 1};
                pg8::StaticOrder S; S.init(MROWS, NINP, G, bid);
                const float* rc = (const float*)(a->ws + WS_ROPE);
                EpiMix E{(bf16_t*)(a->ws + WS_QR), (bf16_t*)(a->ws + WS_KV), (bf16_t*)(a->ws + WS_EW), (float*)(a->ws + WS_GATES), rc, rc + 65536};
                pg8::gemm_phase<EpiMix, pg8::StaticOrder, true, true>(lds, gm, S, E, tid);
                if constexpr (BG_PREP && l == 0) bg_prep(a, lds, (MROWS / 256) * (NINP / 256), 1, G, bid, tid, wave, lane);
            } else if constexpr ((EN & 32) && sub == 5) {
                for (int u = bid; u < 512; u += G) {
                    if (u < 256) compress_unit(a, lds, l, u, tid, wave, lane);
                    else gmlp_unit(a, lds, l, u - 256, tid, wave, lane);
                }
            } else if constexpr ((EN & 64) && sub == 6) {
                for (int u = bid; u < 512; u += G) {
                    const int bg = u & 15, k = (u >> 4) & 15, qt = (u < 256) ? 31 - k : k;
                    attn_unit(a, lds, bg >> 1, bg & 1, qt, tid, wave, lane);
                }
            } else if constexpr ((EN & 128) && sub == 7) {
                pg8::StaticOrder S; S.init(MROWS, 1024, G, bid);
                { pg8::Gemm gm{(const pg8::bf16_t*)(a->ws + WS_YA), (const pg8::bf16_t*)(a->ws + WS_WPA) + (size_t)l * 1024 * 512, MROWS, 1024, 512, 0, 1};
                  EpiProj<0> E{(const bf16_t*)(a->ws + WS_EW), (bf16_t*)(a->ws + WS_MG)};
                  pg8::gemm_phase<EpiProj<0>, pg8::StaticOrder, true, true>(lds, gm, S, E, tid); }
                { pg8::Gemm gm{(const pg8::bf16_t*)(a->ws + WS_YB), (const pg8::bf16_t*)(a->ws + WS_WPB) + (size_t)l * 1024 * 512, MROWS, 1024, 512, 0, 1};
                  EpiProj<1> E{(const bf16_t*)(a->ws + WS_EW), (bf16_t*)(a->ws + WS_MG)};
                  pg8::gemm_phase<EpiProj<1>, pg8::StaticOrder, true, true>(lds, gm, S, E, tid); }
            } else if constexpr ((EN & 256) && sub == 8) {
                pg8::Gemm gm{(const pg8::bf16_t*)(a->ws + WS_MG), (const pg8::bf16_t*)(a->ws + WS_WO) + (size_t)l * 1024 * 1024, MROWS, 1024, 1024, 0, 1};
                EpiResid E{a->out, a->out, modp, adab, l, 5 * 1024, 1.0f};
                if constexpr (FUSE_NORM) {
                    PanelNormOrder S; S.init(MROWS, 1024, G, bid);
                    S.cnt = (unsigned*)(a->ws + WS_CNT) + (l * 3 + 1) * 1024; S.xtab = (const unsigned*)(a->ws + WS_XT); S.lds = lds; S.h = a->out; S.fout = a->out; S.XN = (bf16_t*)(a->ws + WS_XN);
                    S.modp = modp; S.adab = adab; S.gvec = a->in[4] + (l * 3 + 2) * 1024; S.l = l; S.i = 2; S.fin = 0; S.tid = tid;
                    pg8::gemm_phase<EpiResid, PanelNormOrder, true, true>(lds, gm, S, E, tid);
                } else {
                    pg8::StaticOrder S; S.init(MROWS, 1024, G, bid);
                    pg8::gemm_phase<EpiResid, pg8::StaticOrder, true, true>(lds, gm, S, E, tid);
                }
            }
        }
}
template <int ph> __device__ __forceinline__ void run_phase(LAS unsigned char* lds, cg::grid_group& grid, const int wave_in) {
    constexpr bool fused_away = FUSE_NORM && (ph == N_PHASES - 1 || (ph >= 1 && ((ph - 1) % 12 == 3 || (ph - 1) % 12 == 9 || ph == 13)));
    if constexpr (!fused_away) {
        CArgsP a = (CArgsP)__builtin_amdgcn_kernarg_segment_ptr();
        phase_work<ph>(lds, wave_in);
        constexpr bool again = (PROBE_REP && ph >= 1 && ph < N_PHASES - 1 && ((PROBE_REP >> ((ph - 1) % 12)) & 1)) || (ph == 0 && (PROBE_REP & 4096)) || (ph == 3 && (PROBE_REP & 8192));
        if constexpr (again) { GRID_BAR(); phase_work<ph>(lds, wave_in); }
        if constexpr (PROBE_SYNC >= 1) GRID_BAR();
        if constexpr (PROBE_SYNC >= 2) GRID_BAR();
        if constexpr (ph + 1 < N_PHASES - (FUSE_NORM ? 1 : 0)) { if constexpr (ph == 0) { if (a->ph_hi == 12345) grid.sync(); } GRID_BAR(); }
    }
}
__global__ void __launch_bounds__(NTHR, 2) fwd_kernel(Args a_by_value) {
    CArgsP a = (CArgsP)__builtin_amdgcn_kernarg_segment_ptr();
    extern __shared__ __attribute__((aligned(16))) unsigned char lds_raw[];
    LAS unsigned char* lds = (LAS unsigned char*)lds_raw;
    cg::grid_group grid = cg::this_grid();
    volatile LAS unsigned* bst = (volatile LAS unsigned*)(lds + 131072 + 256);
    if (threadIdx.x < 2) bst[threadIdx.x] = 0u;
    __syncthreads();
    (void)xcd_barrier_post((unsigned*)(a->ws + WS_BAR), bst);
    const int wv = __builtin_amdgcn_readfirstlane(threadIdx.x >> 6);
    run_phase<0>(lds, grid, wv); run_phase<1>(lds, grid, wv); run_phase<2>(lds, grid, wv); run_phase<3>(lds, grid, wv); run_phase<4>(lds, grid, wv); run_phase<5>(lds, grid, wv); run_phase<6>(lds, grid, wv);
    run_phase<7>(lds, grid, wv); run_phase<8>(lds, grid, wv); run_phase<9>(lds, grid, wv); run_phase<10>(lds, grid, wv); run_phase<11>(lds, grid, wv); run_phase<12>(lds, grid, wv); run_phase<13>(lds, grid, wv);
    run_phase<14>(lds, grid, wv); run_phase<15>(lds, grid, wv); run_phase<16>(lds, grid, wv); run_phase<17>(lds, grid, wv); run_phase<18>(lds, grid, wv); run_phase<19>(lds, grid, wv); run_phase<20>(lds, grid, wv);
    run_phase<21>(lds, grid, wv); run_phase<22>(lds, grid, wv); run_phase<23>(lds, grid, wv); run_phase<24>(lds, grid, wv); run_phase<25>(lds, grid, wv);
}

extern "C" void kernel_launch(void* const* d_in, const int* in_sizes, int n_in, void* d_out, int out_size, void* d_ws, size_t ws_size, hipStream_t stream) {
    static int grid = 0;
    if (grid == 0) {
        if (n_in != 19 || out_size != MROWS * DM || ws_size < WS_END) { fprintf(stderr, "kernel_launch: unexpected shapes (n_in %d out %d ws %zu)\n", n_in, out_size, ws_size); grid = -1; return; }
        int dev = 0, cus = 0, per_cu = 0;
        hipGetDevice(&dev);
        hipDeviceGetAttribute(&cus, hipDeviceAttributeMultiprocessorCount, dev);
        if (hipFuncSetAttribute((const void*)fwd_kernel, hipFuncAttributeMaxDynamicSharedMemorySize, LDS_BYTES) != hipSuccess) { fprintf(stderr, "kernel_launch: hipFuncSetAttribute failed\n"); grid = -1; return; }
        if (hipOccupancyMaxActiveBlocksPerMultiprocessor(&per_cu, (const void*)fwd_kernel, NTHR, LDS_BYTES) != hipSuccess || per_cu < 1) { fprintf(stderr, "kernel_launch: occupancy query gave %d\n", per_cu); per_cu = 1; }
        (void)hipGetLastError();
        grid = cus * 1;
        if (grid > 256) grid = 256;
    }
    if (grid < 0) return;
    if (hipMemsetAsync((char*)d_ws + WS_BAR, 0, 16384 + 6 * 1024 * 4, stream) != hipSuccess) { fprintf(stderr, "kernel_launch: memset failed\n"); return; }
    Args a{};
    for (int i = 0; i < 19; ++i) a.in[i] = (const float*)d_in[i];
    a.out = (float*)d_out; a.ws = (unsigned char*)d_ws; a.ph_lo = 0; a.ph_hi = N_PHASES;
    void* args[] = {&a};
    hipError_t e = hipLaunchCooperativeKernel((const void*)fwd_kernel, dim3(grid), dim3(NTHR), args, LDS_BYTES, stream);
    if (e != hipSuccess) fprintf(stderr, "cooperative launch failed: %s (grid %d)\n", hipGetErrorString(e), grid);
}
```

```cpp
#include <hip/hip_runtime.h>
#include <hip/hip_cooperative_groups.h>
#include <cstdio>
#include <cstdint>
namespace cg = cooperative_groups;
namespace pg8 {
#define PG8_LAS __attribute__((address_space(3)))
typedef unsigned short bf16_t;
typedef short bf16x8 __attribute__((ext_vector_type(8)));
typedef float f32x4 __attribute__((ext_vector_type(4)));
typedef unsigned u32x4 __attribute__((ext_vector_type(4)));
constexpr int BM = 256, BK = 64, HALF = 128, HTB = HALF * BK * 2  , STAGE_BYTES = 8 * HTB, NXCD = 8, WGM = 8;

__host__ __device__ __forceinline__ int lds_byte(int r, int c) { const int st = (r >> 4) * 2 + (c >> 5), rr = r & 15, cc = c & 31, ob = rr * 64 + cc * 2; return st * 1024 + (ob ^ (((ob >> 9) & 1) << 5)); }
__host__ __device__ __forceinline__ void stage_rc(int b, int& R, int& C) { const int st = b / 1024, sb = b % 1024, swz = sb ^ (((sb >> 9) & 1) << 5); R = (st >> 1) * 16 + swz / 64; C = (st & 1) * 32 + (swz % 64) / 2; }
__host__ __device__ __forceinline__ int perm32(int rho) { const int n = rho >> 4, i = rho & 15; return 8 * (i >> 2) + 4 * n + (i & 3); }

struct Unit { int pm, pn; };
struct Gemm { const bf16_t* A; const bf16_t* Bt; int M, N, K; int a_tiled, b_tiled; };

struct StaticOrder {
    int nM, nN, nwg, G, c;
    __host__ __device__ void init(int M, int N, int G_, int c_) { nM = M / BM; nN = N / BM; nwg = nM * nN; G = G_; c = c_; }
    __host__ __device__ bool next(int i, Unit& u) const {
        const long L = (long)i * G + c; if (L >= nwg) return false;
        int wgid = (int)L; { const int q = nwg / NXCD, r = nwg % NXCD, xcd = wgid % NXCD, off = wgid / NXCD; wgid = (xcd < r ? xcd * (q + 1) : r * (q + 1) + (xcd - r) * q) + off; }
        const int nig = WGM * nN, gid = wgid / nig, fm = gid * WGM, gsz = (nM - fm) < WGM ? (nM - fm) : WGM;
        u.pm = fm + ((wgid % nig) % gsz); u.pn = (wgid % nig) / gsz; return true;
    }
    __device__ __forceinline__ void a_ready(const Unit&) const {}
    __device__ __forceinline__ void done(const Unit&) const {}
};

__device__ __forceinline__ unsigned cvt_pk_bf16(float lo, float hi) { unsigned r; asm volatile("v_cvt_pk_bf16_f32 %0, %1, %2" : "=v"(r) : "v"(lo), "v"(hi)); return r; }
template <class Epi, class Sched, bool ALIGN_EPI = false, bool SP2 = false>
__device__ __forceinline__ void gemm_phase(PG8_LAS unsigned char* lds, const Gemm g, const Sched& S, const Epi& E, const int tid_in) {
    const int tid = tid_in, wid = __builtin_amdgcn_readfirstlane(tid >> 6), lane = tid & 63, wr = wid >> 2, wc = wid & 3, fr = lane & 15, fq = lane >> 4;
    const int K = g.K, nt = K / BK;
    unsigned voffA[2], voffB[2];
#pragma unroll
    for (int i = 0; i < 2; ++i) { int R, C; stage_rc(tid * 16 + i * 8192, R, C); const int Rb = Epi::PERM ? ((R & ~31) + perm32(R & 31)) : R;
        voffA[i] = (unsigned)(R * (g.a_tiled ? BK : K) + C) * 2u; voffB[i] = (unsigned)(Rb * (g.b_tiled ? BK : K) + C) * 2u; }
    const size_t kstep = (size_t)(BK * 2);
    const size_t hstep = (size_t)HALF * K * 2;
    const size_t tstep = 2 * hstep;
    const size_t kstepA = g.a_tiled ? (size_t)BM * BK * 2 : kstep, hstepA = g.a_tiled ? (size_t)HALF * BK * 2 : hstep, tstepA = g.a_tiled ? (size_t)(K / BK) * BM * BK * 2 : tstep;
    const size_t kstepB = g.b_tiled ? (size_t)BM * BK * 2 : kstep, hstepB = g.b_tiled ? (size_t)HALF * BK * 2 : hstep, tstepB = g.b_tiled ? (size_t)(K / BK) * BM * BK * 2 : tstep;
    const unsigned ldsw = (unsigned)wid * 1024u;
    const int aoff = lds_byte(wr * 64 + fr, fq * 8), boff = lds_byte(wc * 32 + fr, fq * 8);
#define PG8_SA(b, h) (((b) * 2 + (h)) * HTB)
#define PG8_SB(b, h) ((4 + (b) * 2 + (h)) * HTB)
#define PG8_STAGE(bufoff, gbase, voff) do { _Pragma("unroll") for (int _i = 0; _i < 2; ++_i) \
        __builtin_amdgcn_global_load_lds((const unsigned*)((const char*)(gbase) + (voff)[_i]), (PG8_LAS unsigned*)(lds + (bufoff) + ldsw + _i * 8192), 16, 0, 0); } while (0)
#define PG8_LDA(dst, b, h) do { _Pragma("unroll") for (int m = 0; m < 4; ++m) _Pragma("unroll") for (int k = 0; k < 2; ++k) dst[m][k] = *(const PG8_LAS bf16x8*)(lds + PG8_SA(b, h) + aoff + m * 2048 + k * 1024); } while (0)
#define PG8_LDB(dst, b, h) do { _Pragma("unroll") for (int n = 0; n < 2; ++n) _Pragma("unroll") for (int k = 0; k < 2; ++k) dst[n][k] = *(const PG8_LAS bf16x8*)(lds + PG8_SB(b, h) + boff + n * 2048 + k * 1024); } while (0)
#define PG8_MMA(ai, bj, At, Bt) do { __builtin_amdgcn_s_setprio(1); _Pragma("unroll") for (int m = 0; m < 4; ++m) _Pragma("unroll") for (int n = 0; n < 2; ++n) _Pragma("unroll") for (int k = 0; k < 2; ++k) \
        acc[ai][bj][m][n] = __builtin_amdgcn_mfma_f32_16x16x32_bf16(Bt[n][k], At[m][k], acc[ai][bj][m][n], 0, 0, 0); __builtin_amdgcn_s_setprio(0); } while (0)
#define PG8_WAIT_V(n) asm volatile("s_waitcnt vmcnt(" #n ")" ::: "memory")
#define PG8_WAIT_L(n) asm volatile("s_waitcnt lgkmcnt(" #n ")" ::: "memory")
#define PG8_BAR __builtin_amdgcn_s_barrier()
#define PG8_SCHED __builtin_amdgcn_sched_barrier(0)
    Unit cur, nxt; int ui = 0;
    if (!S.next(0, cur)) return;
    f32x4 acc[2][2][4][2];
#pragma unroll
    for (int a = 0; a < 2; ++a)
#pragma unroll
        for (int b = 0; b < 2; ++b)
#pragma unroll
            for (int m = 0; m < 4; ++m)
#pragma unroll
                for (int n = 0; n < 2; ++n) acc[a][b][m][n] = (f32x4){0.f, 0.f, 0.f, 0.f};
    bf16x8 At[4][2], B0[2][2], B1[2][2];
    const char* cA = (const char*)g.A + (size_t)cur.pm * tstepA; const char* cB = (const char*)g.Bt + (size_t)cur.pn * tstepB;
    S.a_ready(cur);
    if constexpr (SP2) {
        PG8_STAGE(PG8_SB(0, 0), cB, voffB); PG8_STAGE(PG8_SB(0, 1), cB + hstepB, voffB); PG8_STAGE(PG8_SA(0, 0), cA, voffA); PG8_STAGE(PG8_SA(0, 1), cA + hstepA, voffA);
        if (wr == 1) PG8_BAR;
        PG8_WAIT_V(2); PG8_BAR;
        PG8_STAGE(PG8_SB(1, 0), cB + kstepB, voffB); PG8_STAGE(PG8_SA(1, 0), cA + kstepA, voffA); PG8_STAGE(PG8_SB(1, 1), cB + hstepB + kstepB, voffB);
        PG8_WAIT_V(6); PG8_BAR;
    } else {
        PG8_STAGE(PG8_SB(0, 0), cB, voffB); PG8_STAGE(PG8_SA(0, 0), cA, voffA); PG8_STAGE(PG8_SB(0, 1), cB + hstepB, voffB); PG8_STAGE(PG8_SA(0, 1), cA + hstepA, voffA);
        if (wr == 1) PG8_BAR;
        PG8_WAIT_V(4); PG8_BAR;
        PG8_STAGE(PG8_SB(1, 0), cB + kstepB, voffB); PG8_STAGE(PG8_SA(1, 0), cA + kstepA, voffA); PG8_STAGE(PG8_SB(1, 1), cB + hstepB + kstepB, voffB);
        PG8_WAIT_V(6); PG8_BAR;
    }
    for (;;) {
        const bool has_next = S.next(ui + 1, nxt);
        const char* nA = has_next ? (const char*)g.A + (size_t)nxt.pm * tstepA : cA; const char* nB = has_next ? (const char*)g.Bt + (size_t)nxt.pn * tstepB : cB;
        for (int t = 0; t < nt; t += 2) {
            const bool last = (t == nt - 2);
            const char* a1 = cA + (size_t)(t + 1) * kstepA;
            const char* a2 = last ? nA : cA + (size_t)(t + 2) * kstepA; const char* b2 = last ? nB : cB + (size_t)(t + 2) * kstepB;
            const char* a3 = a2 + kstepA; const char* b3 = b2 + kstepB;
            if (last && has_next) S.a_ready(nxt);
            if constexpr (SP2) {
            PG8_LDB(B0, 0, 0); PG8_LDB(B1, 0, 1); PG8_SCHED; PG8_LDA(At, 0, 0); PG8_STAGE(PG8_SA(1, 1), a1 + hstepA, voffA);
            PG8_WAIT_V(8); PG8_WAIT_L(0); PG8_BAR; PG8_MMA(0, 0, At, B0); PG8_MMA(0, 1, At, B1); PG8_BAR; PG8_SCHED;
            PG8_LDA(At, 0, 1); PG8_STAGE(PG8_SB(0, 0), b2, voffB); PG8_STAGE(PG8_SB(0, 1), b2 + hstepB, voffB); PG8_STAGE(PG8_SA(0, 0), a2, voffA);
            PG8_WAIT_V(8); PG8_WAIT_L(0); PG8_BAR; PG8_MMA(1, 0, At, B0); PG8_MMA(1, 1, At, B1); PG8_BAR; PG8_SCHED;
            PG8_LDB(B0, 1, 0); PG8_LDB(B1, 1, 1); PG8_SCHED; PG8_LDA(At, 1, 0); PG8_STAGE(PG8_SA(0, 1), a2 + hstepA, voffA);
            PG8_WAIT_V(8); PG8_WAIT_L(0); PG8_BAR; PG8_MMA(0, 0, At, B0); PG8_MMA(0, 1, At, B1); PG8_BAR; PG8_SCHED;
            PG8_LDA(At, 1, 1); PG8_STAGE(PG8_SB(1, 0), b3, voffB); PG8_STAGE(PG8_SB(1, 1), b3 + hstepB, voffB); PG8_STAGE(PG8_SA(1, 0), a3, voffA);
            PG8_WAIT_V(8); PG8_WAIT_L(0); PG8_BAR; PG8_MMA(1, 0, At, B0); PG8_MMA(1, 1, At, B1); PG8_BAR; PG8_SCHED;
            } else {
            PG8_LDB(B0, 0, 0); PG8_SCHED; PG8_LDA(At, 0, 0); PG8_STAGE(PG8_SA(1, 1), a1 + hstepA, voffA);
            PG8_WAIT_L(8); PG8_BAR; PG8_WAIT_L(0); PG8_MMA(0, 0, At, B0); PG8_BAR; PG8_SCHED;
            PG8_LDB(B1, 0, 1); PG8_STAGE(PG8_SB(0, 0), b2, voffB);
            PG8_BAR; PG8_WAIT_L(0); PG8_MMA(0, 1, At, B1); PG8_BAR;
            PG8_LDA(At, 0, 1); PG8_STAGE(PG8_SA(0, 0), a2, voffA);
            PG8_BAR; PG8_WAIT_L(0); PG8_MMA(1, 0, At, B0); PG8_BAR; PG8_SCHED;
            PG8_STAGE(PG8_SB(0, 1), b2 + hstepB, voffB);
            PG8_WAIT_V(6); PG8_BAR; PG8_MMA(1, 1, At, B1); PG8_BAR;
            PG8_LDB(B0, 1, 0); PG8_SCHED; PG8_LDA(At, 1, 0); PG8_STAGE(PG8_SA(0, 1), a2 + hstepA, voffA);
            PG8_WAIT_L(8); PG8_BAR; PG8_WAIT_L(0); PG8_MMA(0, 0, At, B0); PG8_BAR; PG8_SCHED;
            PG8_LDB(B1, 1, 1); PG8_STAGE(PG8_SB(1, 0), b3, voffB);
            PG8_BAR; PG8_WAIT_L(0); PG8_MMA(0, 1, At, B1); PG8_BAR;
            PG8_LDA(At, 1, 1); PG8_STAGE(PG8_SA(1, 0), a3, voffA);
            PG8_BAR; PG8_WAIT_L(0); PG8_MMA(1, 0, At, B0); PG8_BAR; PG8_SCHED;
            PG8_STAGE(PG8_SB(1, 1), b3 + hstepB, voffB);
            PG8_WAIT_V(6); PG8_BAR; PG8_MMA(1, 1, At, B1); PG8_BAR;
            }
        }
        if constexpr (ALIGN_EPI) { if (wr == 0) PG8_BAR; }
        if constexpr (!Epi::AFTER_DRAIN) { E(acc, cur, wr, wc, fr, fq); S.done(cur); }
        if (!has_next) break;
#pragma unroll
        for (int a = 0; a < 2; ++a)
#pragma unroll
            for (int b = 0; b < 2; ++b)
#pragma unroll
                for (int m = 0; m < 4; ++m)
#pragma unroll
                    for (int n = 0; n < 2; ++n) acc[a][b][m][n] = (f32x4){0.f, 0.f, 0.f, 0.f};
        cur = nxt; cA = nA; cB = nB; ++ui;
        if constexpr (ALIGN_EPI) { if (wr == 1) PG8_BAR; }
    }
    PG8_WAIT_V(0);
    if constexpr (!ALIGN_EPI) { if (wr == 0) PG8_BAR; }
    PG8_BAR;
    if constexpr (Epi::AFTER_DRAIN) { E.fused(acc, cur, wr, wc, fr, fq, lds, wid, lane); S.done(cur); }
#undef PG8_SA
#undef PG8_SB
#undef PG8_STAGE
#undef PG8_LDA
#undef PG8_LDB
#undef PG8_MMA
#undef PG8_WAIT_V
#undef PG8_WAIT_L
#undef PG8_BAR
#undef PG8_SCHED
}
}

constexpr int BATCH = 8, SEQ = 2048, DM = 1024, MROWS = BATCH * SEQ, DFF = 2816, NFF2 = 2 * DFF, NINP = 4608, NIN = 4376;
constexpr int NWAVES = 8, NTHR = 512;
constexpr int LDS_BYTES = 147456;
constexpr int N_PHASES = 26;
#ifndef EN
#define EN 511
#endif
#ifndef FUSE_NORM
#define FUSE_NORM 1
#endif
#ifndef PROBE_REP
#define PROBE_REP 0
#endif
#ifndef PROBE_SYNC
#define PROBE_SYNC 0
#endif
constexpr float QSCALE = 0.125f * 1.4426950408889634f;
#define LAS __attribute__((address_space(3)))
typedef unsigned short bf16_t;
typedef short bf16x8 __attribute__((ext_vector_type(8)));
typedef short s16x4 __attribute__((ext_vector_type(4)));
typedef float f32x4 __attribute__((ext_vector_type(4)));
typedef float f32x16 __attribute__((ext_vector_type(16)));
typedef unsigned u32x2 __attribute__((ext_vector_type(2)));
typedef unsigned u32x4 __attribute__((ext_vector_type(4)));
#define MFMA32(a, b, c) __builtin_amdgcn_mfma_f32_32x32x16_bf16((a), (b), (c), 0, 0, 0)

constexpr size_t MiB = 1u << 20;
constexpr size_t WS_MODP = 0;
constexpr size_t WS_BAR = 4 * MiB + 768 * 1024;
constexpr size_t WS_CNT = WS_BAR + 16384;
constexpr size_t WS_XT = WS_CNT + 24576;
constexpr size_t WS_ROPE = 5 * MiB;
constexpr size_t WS_PECP = 5 * MiB + 768 * 1024;
constexpr size_t WS_W1T = 6 * MiB;
constexpr size_t WS_KC = 8 * MiB;
constexpr size_t WS_VC = 8 * MiB + 512 * 1024;
constexpr size_t WS_WFI = 10 * MiB;
constexpr size_t WS_WFO = 54 * MiB;
constexpr size_t WS_WMIX = 76 * MiB;
constexpr size_t WS_WPA = 94 * MiB;
constexpr size_t WS_WPB = 96 * MiB;
constexpr size_t WS_WO = 98 * MiB;
constexpr size_t WS_XN = 102 * MiB;
constexpr size_t WS_YA = 102 * MiB, WS_YB = 118 * MiB;
constexpr size_t WS_HID = 134 * MiB;
constexpr size_t WS_QR = 134 * MiB;
constexpr size_t WS_KV = 150 * MiB;
constexpr size_t WS_EW = 176 * MiB;
constexpr size_t WS_GATES = 272 * MiB;
constexpr size_t WS_MG = 134 * MiB;
constexpr size_t WS_END = 274 * MiB;

struct Args { const float* in[19]; float* out; unsigned char* ws; int ph_lo, ph_hi; };
typedef const __attribute__((address_space(4))) Args* CArgsP;

__device__ __forceinline__ unsigned pk2(float lo, float hi) {
    typedef float f2 __attribute__((ext_vector_type(2))); typedef __bf16 b2 __attribute__((ext_vector_type(2)));
    f2 v = {lo, hi}; b2 b = __builtin_convertvector(v, b2); return __builtin_bit_cast(unsigned, b);
}
__device__ __forceinline__ float bf_lo(unsigned u) { return __uint_as_float(u << 16); }
__device__ __forceinline__ float bf_hi(unsigned u) { return __uint_as_float(u & 0xffff0000u); }
__device__ __forceinline__ float fexp2(float x) { return __builtin_amdgcn_exp2f(x); }
__device__ __forceinline__ float frcp(float x) { return __builtin_amdgcn_rcpf(x); }
__device__ __forceinline__ float sigm(float x) { return frcp(1.f + fexp2(-1.4426950408889634f * x)); }
__device__ __forceinline__ float silu_f(float x) { return x * sigm(x); }
__device__ __forceinline__ float gelu_tanh_f(float x) { return x * sigm(1.5957691216057308f * (x + 0.044715f * x * x * x)); }
__device__ __forceinline__ float wave_sum(float v) {
#pragma unroll
    for (int o = 1; o < 64; o <<= 1) v += __shfl_xor(v, o);
    return v;
}
__device__ __forceinline__ float xhalf_max(float v) { const auto r = __builtin_amdgcn_permlane32_swap(__float_as_uint(v), __float_as_uint(v), false, false); return fmaxf(__uint_as_float(r[0]), __uint_as_float(r[1])); }
__device__ __forceinline__ float xhalf_sum(float v) { const auto r = __builtin_amdgcn_permlane32_swap(__float_as_uint(v), __float_as_uint(v), false, false); return __uint_as_float(r[0]) + __uint_as_float(r[1]); }
__device__ __forceinline__ float xhalf_other(float v, int hi) { const auto r = __builtin_amdgcn_permlane32_swap(__float_as_uint(v), __float_as_uint(v), false, false); return __uint_as_float(hi ? r[0] : r[1]); }
__device__ __forceinline__ int crow(int r, int hi) { return (r & 3) + 8 * (r >> 2) + 4 * hi; }
__device__ __forceinline__ s16x4 tr_read(LAS unsigned char* p) { return __builtin_amdgcn_ds_read_tr16_b64_v4i16((LAS s16x4*)p); }
__device__ __forceinline__ bf16x8 cat8(s16x4 a, s16x4 b) { return __builtin_shufflevector(a, b, 0, 1, 2, 3, 4, 5, 6, 7); }
#define PACK8(S, sp) ({ u32x4 _p; _p.x = pk2((S)[8 * (sp) + 0], (S)[8 * (sp) + 1]); _p.y = pk2((S)[8 * (sp) + 2], (S)[8 * (sp) + 3]); \
                        _p.z = pk2((S)[8 * (sp) + 4], (S)[8 * (sp) + 5]); _p.w = pk2((S)[8 * (sp) + 6], (S)[8 * (sp) + 7]); __builtin_bit_cast(bf16x8, _p); })

__device__ __forceinline__ unsigned xb_xcc_id();
__device__ __forceinline__ f32x4 modv4(const float* modp, const float* adab, int l, int b, int idx) {
    f32x4 s = *(const f32x4*)(adab + l * 9216 + idx);
#pragma unroll
    for (int kc = 0; kc < 8; ++kc) s += *(const f32x4*)(modp + (size_t)((l * 8 + kc) * 8 + b) * 9216 + idx);
    return s;
}

__device__ __forceinline__ int rowmap(int mode, int n) {
    if (mode == 1) { return n < DFF ? ((n >> 7) * 256 + (n & 127)) : (((n - DFF) >> 7) * 256 + 128 + ((n - DFF) & 127)); }
    if (mode == 2) {
        if (n >= 1304) return n - 24;
        if (n >= 1280) return 4352 + (n - 1280);
        { const int d = n & 63; return (n & ~63) | (((d >> 4) & 1) << 5) | (((d >> 2) & 3) << 3) | ((d >> 5) << 2) | (d & 3); }
    }
    return n;
}
__device__ __forceinline__ void tr_item(const float* W, int K, int N, bf16_t* WT, int mode, LAS float* scr, int item, int lane, int tiled = 1) {
    const int nblk = (N + 31) / 32, kb = item / nblk, nb = item % nblk, k0 = 64 * kb, n0 = 32 * nb;
    const int nn = n0 + (lane & 31);
    float tv[32];
    const float* wp = W + (size_t)(k0 + (lane >> 5)) * N + (nn < N ? nn : 0);
#pragma unroll
    for (int i = 0; i < 32; ++i) tv[i] = wp[(size_t)(2 * i) * N];
#pragma unroll
    for (int i = 0; i < 32; ++i) scr[(2 * i + (lane >> 5)) * 33 + (lane & 31)] = (nn < N) ? tv[i] : 0.f;
    asm volatile("s_waitcnt lgkmcnt(0)" ::: "memory");
    const int c = lane & 7;
#pragma unroll
    for (int j = 0; j < 4; ++j) {
        const int n = (lane >> 3) + 8 * j; const LAS float* s = scr + (8 * c) * 33 + n;
        u32x4 o; o.x = pk2(s[0 * 33], s[1 * 33]); o.y = pk2(s[2 * 33], s[3 * 33]); o.z = pk2(s[4 * 33], s[5 * 33]); o.w = pk2(s[6 * 33], s[7 * 33]);
        if (n0 + n < N) {
            const int pr = rowmap(mode, n0 + n);
            const size_t off = tiled ? ((size_t)((pr >> 8) * (K >> 6) + (k0 >> 6)) * 256 + (pr & 255)) * 64 + 8 * c : (size_t)pr * K + k0 + 8 * c;
            *(u32x4*)(WT + off) = o;
        }
    }
    asm volatile("s_waitcnt lgkmcnt(0)" ::: "memory");
}

constexpr int I_FI = 16 * 176, I_FO = 44 * 32, I_MIX = 16 * 137, I_P = 8 * 32, I_O = 16 * 32, I_W1 = 32 * 4;
constexpr int LAYER_ITEMS = 1152 + 2 * I_FI + 2 * I_FO + I_MIX + 2 * I_P + I_O + 2 * I_W1 + 64;
#ifndef BG_PREP
#define BG_PREP 1
#endif
__device__ __forceinline__ void prep_sc(CArgsP a, LAS unsigned char* lds, int tid) {
    LAS float* SC = (LAS float*)lds; const float* c = a->in[1];
    __syncthreads();
    for (int i = tid; i < 8192; i += NTHR) { const float v = c[i]; SC[i] = silu_f(v); }
    __syncthreads();
}
__device__ __forceinline__ void prep_items(CArgsP a, LAS unsigned char* lds, int l, int lo, int hi, int first, int stride, int wave, int lane) {
    LAS float* SC = (LAS float*)lds;
    LAS float* scr = (LAS float*)(lds + 32768 + wave * 8448);
    bf16_t* WFI = (bf16_t*)(a->ws + WS_WFI); bf16_t* WFO = (bf16_t*)(a->ws + WS_WFO); bf16_t* WMIX = (bf16_t*)(a->ws + WS_WMIX);
    bf16_t* WPA = (bf16_t*)(a->ws + WS_WPA); bf16_t* WPB = (bf16_t*)(a->ws + WS_WPB); bf16_t* WO = (bf16_t*)(a->ws + WS_WO); bf16_t* W1T = (bf16_t*)(a->ws + WS_W1T);
    for (int it = lo + first; it < hi; it += stride) {
        int r = it;
        if (r < 1152) {
            const float* ada_w = a->in[2]; float* modp = (float*)(a->ws + WS_MODP);
            const int cb = r >> 3, kc = r & 7, col = cb * 64 + lane;
            const float* W = ada_w + (size_t)l * 1024 * 9216 + col;
            float acc[8];
#pragma unroll
            for (int b = 0; b < 8; ++b) acc[b] = 0.f;
            for (int k16 = 0; k16 < 8; ++k16) {
                const int kb = kc * 128 + k16 * 16;
                float wv[16];
#pragma unroll
                for (int i = 0; i < 16; ++i) wv[i] = W[(size_t)(kb + i) * 9216];
#pragma unroll
                for (int i4 = 0; i4 < 4; ++i4)
#pragma unroll
                    for (int b = 0; b < 8; ++b) { const f32x4 sv = *(const LAS f32x4*)(SC + b * 1024 + kb + 4 * i4); acc[b] += sv.x * wv[4 * i4] + sv.y * wv[4 * i4 + 1] + sv.z * wv[4 * i4 + 2] + sv.w * wv[4 * i4 + 3]; }
            }
#pragma unroll
            for (int b = 0; b < 8; ++b) modp[(size_t)((l * 8 + kc) * 8 + b) * 9216 + col] = acc[b];
            continue;
        }
        r -= 1152;
        if (r < 2 * I_FI) { const int w = l * 2 + r / I_FI; tr_item(a->in[5] + (size_t)w * 1024 * NFF2, 1024, NFF2, WFI + (size_t)w * NFF2 * 1024, 1, scr, r % I_FI, lane); continue; } r -= 2 * I_FI;
        if (r < 2 * I_FO) { const int w = l * 2 + r / I_FO; tr_item(a->in[6] + (size_t)w * DFF * 1024, DFF, 1024, WFO + (size_t)w * 1024 * DFF, 0, scr, r % I_FO, lane); continue; } r -= 2 * I_FO;
        if (r < I_MIX) { tr_item(a->in[7] + (size_t)l * 1024 * NIN, 1024, NIN, WMIX + (size_t)l * NINP * 1024, 2, scr, r, lane); continue; } r -= I_MIX;
        if (r < I_P) { tr_item(a->in[15] + (size_t)l * 512 * 1024, 512, 1024, WPA + (size_t)l * 1024 * 512, 0, scr, r, lane); continue; } r -= I_P;
        if (r < I_P) { tr_item(a->in[16] + (size_t)l * 512 * 1024, 512, 1024, WPB + (size_t)l * 1024 * 512, 0, scr, r, lane); continue; } r -= I_P;
        if (r < I_O) { tr_item(a->in[17] + (size_t)l * 1024 * 1024, 1024, 1024, WO + (size_t)l * 1024 * 1024, 0, scr, r, lane); continue; } r -= I_O;
        if (r < 2 * I_W1) { const int w = l * 2 + r / I_W1; tr_item(a->in[9] + (size_t)w * 2048 * 128, 2048, 128, W1T + (size_t)w * 128 * 2048, 0, scr, r % I_W1, lane, 0); continue; } r -= 2 * I_W1;
        {
            const float* pe = a->in[8]; const float* w1 = a->in[9]; float* pecp = (float*)(a->ws + WS_PECP);
            const int lj = l * 2 + (r >> 5), fc = (r >> 4) & 1, kc = r & 15, f = fc * 64 + lane;
            float acc = 0.f;
#pragma unroll 8
            for (int k = kc * 128; k < kc * 128 + 128; ++k) acc += pe[lj * 2048 + k] * w1[((size_t)lj * 2048 + k) * 128 + f];
            pecp[(lj * 16 + kc) * 128 + f] = acc;
        }
    }
}
__device__ __forceinline__ void bg_prep(CArgsP a, LAS unsigned char* lds, int nwg, int half, int G, int bid, int tid, int wave, int lane) {
    const int rem = nwg % G, first_idle = rem, nidle = G - rem;
    if (bid < first_idle) return;
    prep_sc(a, lds, tid);
    const int lo = (LAYER_ITEMS * half) / 3, hi = (LAYER_ITEMS * (half + 1)) / 3;
    prep_items(a, lds, 1, lo, hi, (bid - first_idle) * NWAVES + wave, nidle * NWAVES, wave, lane);
}

__device__ __forceinline__ void phase_prologue(CArgsP a, LAS unsigned char* lds, int tid, int wave, int lane) {
    const int G = gridDim.x, gw = blockIdx.x * NWAVES + wave, NGW = G * NWAVES;
    if (tid == 0) {
        pg8::StaticOrder S; S.init(MROWS, 1024, G, (int)blockIdx.x); pg8::Unit u;
        if (S.next(0, u)) ((unsigned*)(a->ws + WS_XT))[u.pm * 4 + u.pn] = xb_xcc_id() + 1u;
    }
    prep_sc(a, lds, tid);
    prep_items(a, lds, 0, 0, LAYER_ITEMS, gw, NGW, wave, lane);
    if (!BG_PREP) prep_items(a, lds, 1, 0, LAYER_ITEMS, gw, NGW, wave, lane);
    {
        float* rc = (float*)(a->ws + WS_ROPE); float* rs = rc + 65536;
        for (int i = blockIdx.x * NTHR + tid; i < 65536; i += G * NTHR) {
            const int pos = i >> 5, f = i & 31;
            const float inv = exp2f(-(float)f * (13.287712379549449f / 32.f));
            const float angf = (float)pos * inv;
            double t = (double)angf * 0.15915494309189535; t -= floor(t);
            const float tf = (float)t;
            rc[i] = __builtin_amdgcn_cosf(tf); rs[i] = __builtin_amdgcn_sinf(tf);
        }
    }
}

__device__ __forceinline__ void phase_norm(CArgsP a, LAS unsigned char* lds, const float* hin, int l, int sub, int tid, int wave, int lane) {
    LAS float* SH = (LAS float*)lds;
    const float* modp = (const float*)(a->ws + WS_MODP); const float* adab = a->in[3];
    const float* gvec = a->in[4] + (l * 3 + sub) * 1024;
    bf16_t* XN = (bf16_t*)(a->ws + WS_XN);
    for (int blk = blockIdx.x; blk < 256; blk += gridDim.x) {
        const int b = blk >> 5;
        __syncthreads();
        { const int which = tid >> 8, c4 = 4 * (tid & 255);
          f32x4 v = modv4(modp, adab, l, b, (sub * 3 + which) * 1024 + c4);
          if (which) v += 1.f;
          *(LAS f32x4*)(SH + which * 1024 + c4) = v; }
        __syncthreads();
        for (int rr = 0; rr < 8; ++rr) {
            const int row = blk * 64 + wave * 8 + rr;
            const f32x4* xr = (const f32x4*)(hin + (size_t)row * 1024) + lane;
            f32x4 v[4]; float ss = 0.f;
#pragma unroll
            for (int j = 0; j < 4; ++j) { v[j] = xr[64 * j]; ss += (v[j].x * v[j].x + v[j].y * v[j].y) + (v[j].z * v[j].z + v[j].w * v[j].w); }
            const float rstd = rsqrtf(wave_sum(ss) * (1.f / 1024.f) + 1e-6f);
#pragma unroll
            for (int j = 0; j < 4; ++j) {
                const int col = 4 * lane + 256 * j;
                const f32x4 g4 = *(const f32x4*)(gvec + col), sh = *(const LAS f32x4*)(SH + col), sc = *(const LAS f32x4*)(SH + 1024 + col);
                const f32x4 o = (v[j] * rstd) * g4 * sc + sh;
                u32x2 w; w.x = pk2(o.x, o.y); w.y = pk2(o.z, o.w);
                *(u32x2*)(XN + (size_t)row * 1024 + col) = w;
            }
        }
    }
}
__device__ __forceinline__ void phase_final_norm(CArgsP a, int wave, int lane) {
    const float* gvec = a->in[18];
    const int gw = blockIdx.x * NWAVES + wave, NGW = gridDim.x * NWAVES;
    for (int row = gw; row < MROWS; row += NGW) {
        f32x4* xr = (f32x4*)(a->out + (size_t)row * 1024) + lane;
        f32x4 v[4]; float ss = 0.f;
#pragma unroll
        for (int j = 0; j < 4; ++j) { v[j] = xr[64 * j]; ss += (v[j].x * v[j].x + v[j].y * v[j].y) + (v[j].z * v[j].z + v[j].w * v[j].w); }
        const float rstd = rsqrtf(wave_sum(ss) * (1.f / 1024.f) + 1e-6f);
#pragma unroll
        for (int j = 0; j < 4; ++j) { const f32x4 g4 = *(const f32x4*)(gvec + 4 * lane + 256 * j); xr[64 * j] = (v[j] * rstd) * g4; }
    }
}

struct EpiSwiglu {
    static constexpr bool PERM = true, AFTER_DRAIN = false;
    bf16_t* HID;
    __device__ __forceinline__ void operator()(const pg8::f32x4 (&acc)[2][2][4][2], const pg8::Unit& u, int wr, int wc, int fr, int fq) const {
        const int R0 = wr * 64 + fr, hc = u.pn * 128 + wc * 32 + 8 * fq;
        bf16_t* tp = HID + ((size_t)(u.pm * (DFF / 64) + (hc >> 6)) * 256) * 64 + (hc & 63);
#pragma unroll
        for (int ai = 0; ai < 2; ++ai)
#pragma unroll
            for (int m = 0; m < 4; ++m) {
                const pg8::f32x4 x0 = acc[ai][0][m][0], y0 = acc[ai][1][m][0], x1 = acc[ai][0][m][1], y1 = acc[ai][1][m][1];
                u32x4 w;
                w.x = pk2(silu_f(x0[0]) * y0[0], silu_f(x0[1]) * y0[1]); w.y = pk2(silu_f(x0[2]) * y0[2], silu_f(x0[3]) * y0[3]);
                w.z = pk2(silu_f(x1[0]) * y1[0], silu_f(x1[1]) * y1[1]); w.w = pk2(silu_f(x1[2]) * y1[2], silu_f(x1[3]) * y1[3]);
                *(u32x4*)(tp + (size_t)(R0 + ai * 128 + m * 16) * 64) = w;
            }
    }
};
struct EpiResid {
    static constexpr bool PERM = false, AFTER_DRAIN = false;
    const float* hin; float* hout; const float* modp; const float* adab; int l, gidx; float scl;
    __device__ __forceinline__ void operator()(const pg8::f32x4 (&acc)[2][2][4][2], const pg8::Unit& u, int wr, int wc, int fr, int fq) const {
        const int row0 = u.pm * 256 + wr * 64 + fr, b = u.pm >> 3, colb = u.pn * 256 + wc * 32 + 4 * fq;
        f32x4 g4[2][2];
#pragma unroll
        for (int bj = 0; bj < 2; ++bj)
#pragma unroll
            for (int n = 0; n < 2; ++n) g4[bj][n] = modv4(modp, adab, l, b, gidx + colb + bj * 128 + n * 16) * scl;
#pragma unroll
        for (int ai = 0; ai < 2; ++ai)
#pragma unroll
            for (int mh = 0; mh < 2; ++mh) {
                f32x4 hv[2][2][2];
#pragma unroll
                for (int m2 = 0; m2 < 2; ++m2)
#pragma unroll
                    for (int bj = 0; bj < 2; ++bj)
#pragma unroll
                        for (int n = 0; n < 2; ++n) hv[m2][bj][n] = *(const f32x4*)(hin + (size_t)(row0 + ai * 128 + (mh * 2 + m2) * 16) * 1024 + colb + bj * 128 + n * 16);
#pragma unroll
                for (int m2 = 0; m2 < 2; ++m2)
#pragma unroll
                    for (int bj = 0; bj < 2; ++bj)
#pragma unroll
                        for (int n = 0; n < 2; ++n) *(f32x4*)(hout + (size_t)(row0 + ai * 128 + (mh * 2 + m2) * 16) * 1024 + colb + bj * 128 + n * 16) = hv[m2][bj][n] + g4[bj][n] * acc[ai][bj][mh * 2 + m2][n];
            }
    }
};
struct EpiMix {
    static constexpr bool PERM = true, AFTER_DRAIN = false;
    bf16_t *QR, *KV, *EW; float* GATES; const float *rc, *rs;
    __device__ __forceinline__ void operator()(const pg8::f32x4 (&acc)[2][2][4][2], const pg8::Unit& u, int wr, int wc, int fr, int fq) const {
        const int row0 = u.pm * 256 + wr * 64 + fr;
        if (u.pn < 5) {
#pragma unroll
            for (int bj = 0; bj < 2; ++bj) {
                const int blk64 = u.pn * 4 + bj * 2 + (wc >> 1);
                const bool isq = blk64 < 8; const int kvb = blk64 - 8, jkv = kvb >> 1;
                const bool rope = isq || jkv == 2 || jkv == 4;
                const float scl = isq ? QSCALE : 1.f;
                bf16_t* dst = isq ? (QR + blk64 * 64) : (KV + kvb * 64); const int ld = isq ? 512 : 768;
                const int d0 = 16 * (wc & 1) + 4 * fq;
#pragma unroll
                for (int ai = 0; ai < 2; ++ai) {
                    f32x4 csv[4], snv[4];
                    if (rope) {
#pragma unroll
                        for (int m = 0; m < 4; ++m) { const int pos = (row0 + ai * 128 + m * 16) & 2047; csv[m] = *(const f32x4*)(rc + pos * 32 + d0); snv[m] = *(const f32x4*)(rs + pos * 32 + d0); }
                    }
#pragma unroll
                    for (int m = 0; m < 4; ++m) {
                        const int row = row0 + ai * 128 + m * 16;
                        f32x4 v0 = acc[ai][bj][m][0], v1 = acc[ai][bj][m][1];
                        if (rope) {
                            const f32x4 cs = csv[m], sn = snv[m];
                            const f32x4 o0 = v0 * cs - v1 * sn, o1 = v1 * cs + v0 * sn; v0 = o0; v1 = o1;
                        }
                        v0 *= scl; v1 *= scl;
                        u32x2 w0, w1; w0.x = pk2(v0.x, v0.y); w0.y = pk2(v0.z, v0.w); w1.x = pk2(v1.x, v1.y); w1.y = pk2(v1.z, v1.w);
                        bf16_t* rp = dst + (size_t)row * ld + d0;
                        *(u32x2*)rp = w0; *(u32x2*)(rp + 32) = w1;
                    }
                }
            }
        } else if (u.pn < 17) {
            const bool isgelu = u.pn < 9;
#pragma unroll
            for (int bj = 0; bj < 2; ++bj) {
                const int col = (u.pn - 5) * 256 + bj * 128 + wc * 32 + 8 * fq;
#pragma unroll
                for (int ai = 0; ai < 2; ++ai)
#pragma unroll
                    for (int m = 0; m < 4; ++m) {
                        const int row = row0 + ai * 128 + m * 16;
                        u32x4 w;
#pragma unroll
                        for (int n = 0; n < 2; ++n) {
                            const f32x4 v = acc[ai][bj][m][n]; f32x4 o;
                            if (isgelu) { o.x = gelu_tanh_f(v.x); o.y = gelu_tanh_f(v.y); o.z = gelu_tanh_f(v.z); o.w = gelu_tanh_f(v.w); }
                            else { o.x = sigm(v.x); o.y = sigm(v.y); o.z = sigm(v.z); o.w = sigm(v.w); }
                            if (n == 0) { w.x = pk2(o.x, o.y); w.y = pk2(o.z, o.w); } else { w.z = pk2(o.x, o.y); w.w = pk2(o.z, o.w); }
                        }
                        *(u32x4*)(EW + (size_t)row * 3072 + col) = w;
                    }
            }
        } else {
            if (wc == 0) {
#pragma unroll
                for (int n = 0; n < 2; ++n) {
                    const int c = 8 * fq + 4 * n;
                    if (c < 24) {
#pragma unroll
                        for (int ai = 0; ai < 2; ++ai)
#pragma unroll
                            for (int m = 0; m < 4; ++m) {
                                const int row = row0 + ai * 128 + m * 16;
                                const f32x4 v = acc[ai][0][m][n]; f32x4 o; o.x = sigm(v.x); o.y = sigm(v.y); o.z = sigm(v.z); o.w = sigm(v.w);
                                *(f32x4*)(GATES + (size_t)row * 24 + c) = o;
                            }
                    }
                }
            }
        }
    }
};
template <int SECOND> struct EpiProj {
    static constexpr bool PERM = true, AFTER_DRAIN = false;
    const bf16_t* EW; bf16_t* MG;
    __device__ __forceinline__ void operator()(const pg8::f32x4 (&acc)[2][2][4][2], const pg8::Unit& u, int wr, int wc, int fr, int fq) const {
        const int row0 = u.pm * 256 + wr * 64 + fr, colb = u.pn * 256 + wc * 32 + 8 * fq;
#pragma unroll
        for (int ai = 0; ai < 2; ++ai)
#pragma unroll
            for (int mh = 0; mh < 2; ++mh) {
                u32x4 gw[2][2]; unsigned long long pv[2][2][2];
#pragma unroll
                for (int m2 = 0; m2 < 2; ++m2)
#pragma unroll
                    for (int bj = 0; bj < 2; ++bj) {
                        const int row = row0 + ai * 128 + (mh * 2 + m2) * 16, col = colb + bj * 128;
                        gw[m2][bj] = *(const u32x4*)(EW + (size_t)row * 3072 + (SECOND ? 2048 : 1024) + col);
                        if (SECOND) {
                            unsigned long long* mp = (unsigned long long*)(MG + (size_t)row * 1024 + col);
                            pv[m2][bj][0] = __hip_atomic_load(mp, __ATOMIC_RELAXED, __HIP_MEMORY_SCOPE_AGENT);
                            pv[m2][bj][1] = __hip_atomic_load(mp + 1, __ATOMIC_RELAXED, __HIP_MEMORY_SCOPE_AGENT);
                        }
                    }
#pragma unroll
                for (int m2 = 0; m2 < 2; ++m2)
#pragma unroll
                    for (int bj = 0; bj < 2; ++bj) {
                        const int row = row0 + ai * 128 + (mh * 2 + m2) * 16, col = colb + bj * 128;
                        const u32x4 g = gw[m2][bj]; u32x4 w;
#pragma unroll
                        for (int n = 0; n < 2; ++n) {
                            const f32x4 v = acc[ai][bj][mh * 2 + m2][n];
                            const unsigned g0 = n ? g.z : g.x, g1 = n ? g.w : g.y;
                            float o0 = bf_lo(g0) * v.x, o1 = bf_hi(g0) * v.y, o2 = bf_lo(g1) * v.z, o3 = bf_hi(g1) * v.w;
                            if (SECOND) { const unsigned plo = (unsigned)pv[m2][bj][n], phi = (unsigned)(pv[m2][bj][n] >> 32); o0 += bf_lo(plo); o1 += bf_hi(plo); o2 += bf_lo(phi); o3 += bf_hi(phi); }
                            if (n == 0) { w.x = pk2(o0, o1); w.y = pk2(o2, o3); } else { w.z = pk2(o0, o1); w.w = pk2(o2, o3); }
                        }
                        *(u32x4*)(MG + (size_t)row * 1024 + col) = w;
                    }
            }
    }
};

__device__ __forceinline__ void compress_unit(CArgsP a, LAS unsigned char* lds, int l, int u, int tid, int wave, int lane) {
    const int b = u >> 5, g = (u >> 4) & 1, j = (u >> 3) & 1, nb = u & 7;
    LAS float* H = (LAS float*)lds;
    LAS float* OB = H + 16 * 129;
    LAS float* W2s = OB + 16 * 65;
    const bf16_t* KV = (const bf16_t*)(a->ws + WS_KV); const bf16_t* W1T = (const bf16_t*)(a->ws + WS_W1T);
    const float* pecp = (const float*)(a->ws + WS_PECP); const float* w2 = a->in[10] + (size_t)(l * 2 + j) * 128 * 64;
    const float* rc = (const float*)(a->ws + WS_ROPE); const float* rs = rc + 65536;
    const int fr = lane & 15, fq = lane >> 4;
    {
        f32x4 wt[4];
#pragma unroll
        for (int i = 0; i < 4; ++i) wt[i] = *(const f32x4*)(w2 + (i * 512 + tid) * 4);
#pragma unroll
        for (int i = 0; i < 4; ++i) *(LAS f32x4*)(W2s + (i * 512 + tid) * 4) = wt[i];
    }
    {
        const int n = nb * 16 + fr;
        const bf16_t* Ab = KV + (size_t)(b * 2048 + 16 * n) * 768 + (j * 2 + g) * 64;
        const bf16_t* Bb = W1T + (size_t)((l * 2 + j) * 128 + wave * 16 + fr) * 2048;
        f32x4 acc = {0.f, 0.f, 0.f, 0.f};
        bf16x8 a0[4], b0[4], a1[4], b1[4];
#define CMP_LOAD(A_, B_, it_) _Pragma("unroll") for (int i_ = 0; i_ < 4; ++i_) { const int k_ = ((it_) * 4 + i_) * 32 + 8 * fq; A_[i_] = *(const bf16x8*)(Ab + (k_ >> 6) * 768 + (k_ & 63)); B_[i_] = *(const bf16x8*)(Bb + k_); }
#define CMP_MMA(A_, B_) _Pragma("unroll") for (int i_ = 0; i_ < 4; ++i_) acc = __builtin_amdgcn_mfma_f32_16x16x32_bf16(A_[i_], B_[i_], acc, 0, 0, 0);
        CMP_LOAD(a0, b0, 0)
#pragma unroll 1
        for (int it = 0; it < 16; it += 2) {
            CMP_LOAD(a1, b1, it + 1)
            CMP_MMA(a0, b0)
            if (it + 2 < 16) { CMP_LOAD(a0, b0, it + 2) }
            CMP_MMA(a1, b1)
        }
#undef CMP_LOAD
#undef CMP_MMA
#pragma unroll
        for (int r = 0; r < 4; ++r) H[(4 * fq + r) * 129 + wave * 16 + fr] = acc[r];
    }
    __syncthreads();
    {
        const int f = tid & 127; float pec = 0.f;
#pragma unroll
        for (int kc = 0; kc < 16; ++kc) pec += pecp[((l * 2 + j) * 16 + kc) * 128 + f];
#pragma unroll
        for (int i = 0; i < 4; ++i) { const int n = (tid >> 7) + 4 * i; H[n * 129 + f] = silu_f(H[n * 129 + f] + pec); }
    }
    __syncthreads();
    const int n = tid >> 5, d2 = (tid & 31) * 2;
    float o0 = 0.f, o1 = 0.f;
#pragma unroll 8
    for (int f = 0; f < 128; ++f) { const float hv = H[n * 129 + f]; const float w0 = W2s[f * 64 + d2], w1 = W2s[f * 64 + d2 + 1]; o0 += hv * w0; o1 += hv * w1; }
    const int ng = nb * 16 + n;
    if (j == 0) {
        OB[n * 65 + d2] = o0; OB[n * 65 + d2 + 1] = o1;
        __syncthreads();
        const int pos = 16 * ng + 31, dd = d2 & 31;
        const float c0 = rc[pos * 32 + dd], c1 = rc[pos * 32 + dd + 1], s0 = rs[pos * 32 + dd], s1 = rs[pos * 32 + dd + 1];
        const int od = d2 < 32 ? d2 + 32 : d2 - 32;
        const float p0 = OB[n * 65 + od], p1 = OB[n * 65 + od + 1];
        if (d2 < 32) { o0 = o0 * c0 - p0 * s0; o1 = o1 * c1 - p1 * s1; } else { o0 = o0 * c0 + p0 * s0; o1 = o1 * c1 + p1 * s1; }
    }
    if (ng == 127) { o0 = 0.f; o1 = 0.f; }
    bf16_t* dst = (bf16_t*)(a->ws + (j ? WS_VC : WS_KC)) + (size_t)((b * 2 + g) * 128 + ng) * 64 + d2;
    *(unsigned*)dst = pk2(o0, o1);
    __syncthreads();
}

__device__ __forceinline__ void gmlp_unit(CArgsP a, LAS unsigned char* lds, int l, int u, int tid, int wave, int lane) {
    const int b = u >> 5, ch = (u >> 1) & 15, h2 = u & 1;
    const int R0 = b * 2048 + ch * 128;
    const bf16_t* EW = (const bf16_t*)(a->ws + WS_EW); bf16_t* YB = (bf16_t*)(a->ws + WS_YB);
    const float* lng = a->in[11] + l * 512; const float* lnb = a->in[12] + l * 512;
    const float* gws = a->in[13] + (size_t)l * 8 * 128 * 128; const float* gbs = a->in[14] + l * 8 * 128;
    LAS unsigned char* VN = lds;
    {
        const f32x4 g0 = *(const f32x4*)(lng + 8 * lane), g1 = *(const f32x4*)(lng + 8 * lane + 4);
        const f32x4 b0 = *(const f32x4*)(lnb + 8 * lane), b1 = *(const f32x4*)(lnb + 8 * lane + 4);
#pragma unroll 1
        for (int rb = 0; rb < 2; ++rb) {
        u32x4 raw[8];
#pragma unroll
        for (int rr = 0; rr < 8; ++rr) raw[rr] = *(const u32x4*)(EW + (size_t)(R0 + wave * 16 + rb * 8 + rr) * 3072 + 512 + 8 * lane);
#pragma unroll
        for (int rr = 0; rr < 8; ++rr) {
            const int srow = wave * 16 + rb * 8 + rr;
            float x[8] = {bf_lo(raw[rr].x), bf_hi(raw[rr].x), bf_lo(raw[rr].y), bf_hi(raw[rr].y), bf_lo(raw[rr].z), bf_hi(raw[rr].z), bf_lo(raw[rr].w), bf_hi(raw[rr].w)};
            float s = 0.f;
#pragma unroll
            for (int i = 0; i < 8; ++i) s += x[i];
            const float mu = wave_sum(s) * (1.f / 512.f);
            float qv = 0.f;
#pragma unroll
            for (int i = 0; i < 8; ++i) { x[i] -= mu; qv += x[i] * x[i]; }
            const float rstd = rsqrtf(wave_sum(qv) * (1.f / 512.f) + 1e-6f);
            u32x4 o;
            o.x = pk2(x[0] * rstd * g0.x + b0.x, x[1] * rstd * g0.y + b0.y); o.y = pk2(x[2] * rstd * g0.z + b0.z, x[3] * rstd * g0.w + b0.w);
            o.z = pk2(x[4] * rstd * g1.x + b1.x, x[5] * rstd * g1.y + b1.y); o.w = pk2(x[6] * rstd * g1.z + b1.z, x[7] * rstd * g1.w + b1.w);
            if ((lane >> 5) == h2) *(LAS u32x4*)(VN + srow * 576 + (lane & 31) * 16) = o;
        }
        }
    }
    __syncthreads();
    const int tb = wave >> 1, cb = wave & 1, q = lane & 31, hi = lane >> 5, blk = (lane >> 4) & 1, qq = (lane & 15) >> 2, p = lane & 3;
    const int t = 32 * tb + q, kmax = 2 * tb + 1;
    for (int gl = 0; gl < 4; ++gl) {
        const int g = h2 * 4 + gl;
        const float* wrow = gws + ((size_t)g * 128 + t) * 128;
        const int c = 64 * g + 32 * cb + q;
        f32x4 wa[8], wb[8];
#pragma unroll
        for (int ks = 0; ks < 8; ++ks) if (ks <= kmax) { wa[ks] = *(const f32x4*)(wrow + 16 * ks + 8 * hi); wb[ks] = *(const f32x4*)(wrow + 16 * ks + 8 * hi + 4); }
        unsigned short ur[16]; float br[16];
#pragma unroll
        for (int r = 0; r < 16; ++r) { const int tt = 32 * tb + crow(r, hi); ur[r] = EW[(size_t)(R0 + tt) * 3072 + c]; br[r] = gbs[g * 128 + tt]; }
        f32x16 acc;
#pragma unroll
        for (int i = 0; i < 16; ++i) acc[i] = 0.f;
#pragma unroll
        for (int ks = 0; ks < 8; ++ks) if (ks <= kmax) {
            const int s0 = 16 * ks + 8 * hi;
            const f32x4 w0 = wa[ks], w1 = wb[ks];
            u32x4 ap;
            ap.x = pk2(s0 + 0 <= t ? w0.x : 0.f, s0 + 1 <= t ? w0.y : 0.f); ap.y = pk2(s0 + 2 <= t ? w0.z : 0.f, s0 + 3 <= t ? w0.w : 0.f);
            ap.z = pk2(s0 + 4 <= t ? w1.x : 0.f, s0 + 5 <= t ? w1.y : 0.f); ap.w = pk2(s0 + 6 <= t ? w1.z : 0.f, s0 + 7 <= t ? w1.w : 0.f);
            LAS unsigned char* vp = VN + (16 * ks + 8 * hi + qq) * 576 + (64 * gl + 32 * cb + 16 * blk + 4 * p) * 2;
            const s16x4 lo = tr_read(vp), hi4 = tr_read(vp + 4 * 576);
            acc = MFMA32(__builtin_bit_cast(bf16x8, ap), cat8(lo, hi4), acc);
        }
#pragma unroll
        for (int r = 0; r < 16; ++r) {
            const int tt = 32 * tb + crow(r, hi); const size_t row = (size_t)(R0 + tt);
            const float y = __uint_as_float((unsigned)ur[r] << 16) * (acc[r] + br[r]);
            YB[row * 512 + c] = (bf16_t)(pk2(y, 0.f) & 0xffffu);
        }
    }
    __syncthreads();
}

constexpr int AT_BUF2 = 107520;
constexpr int AT_KT = 0, AT_VT = 9216, AT_KC = 21504, AT_VC = 39936, AT_IMP4 = 64512, AT_IMPF = AT_IMP4 + 33792, AT_SELM = AT_IMPF + 8448;

template <int MODE>
__device__ __forceinline__ void attn_tile(LAS unsigned char* KT, LAS unsigned char* VT, const bf16x8 (&qf)[4], float& m, float& lsum, f32x16 (&O)[2], int lane, int srel, bool mine, bool needmask) {
    const int q = lane & 31, hi = lane >> 5, blk = (lane >> 4) & 1, qq = (lane & 15) >> 2, p = lane & 3;
    f32x16 S0, S1;
#pragma unroll
    for (int i = 0; i < 16; ++i) { S0[i] = 0.f; S1[i] = 0.f; }
#pragma unroll
    for (int c = 0; c < 4; ++c) {
        const bf16x8 k0 = *(const LAS bf16x8*)(KT + q * 144 + (16 * c + 8 * hi) * 2);
        const bf16x8 k1 = *(const LAS bf16x8*)(KT + (32 + q) * 144 + (16 * c + 8 * hi) * 2);
        S0 = MFMA32(k0, qf[c], S0); S1 = MFMA32(k1, qf[c], S1);
    }
    if (needmask) {
#pragma unroll
        for (int r = 0; r < 16; ++r) {
            const int kk = crow(r, hi);
            bool v0, v1;
            if (MODE == 1) { v0 = mine && (kk <= srel); v1 = mine && (kk + 32 <= srel); }
            else { v0 = (kk <= srel) && (kk > srel - 512); v1 = (kk + 32 <= srel) && (kk + 32 > srel - 512); }
            S0[r] = v0 ? S0[r] : -1e30f; S1[r] = v1 ? S1[r] : -1e30f;
        }
    }
    float mx = fmaxf(S0[0], S1[0]);
#pragma unroll
    for (int r = 1; r < 16; ++r) mx = fmaxf(mx, fmaxf(S0[r], S1[r]));
    mx = xhalf_max(mx);
    if (__ballot(mx > m + 6.f) != 0ull) {
        const float mnew = fmaxf(m, mx), alpha = fexp2(m - mnew);
        m = mnew; lsum *= alpha;
#pragma unroll
        for (int i = 0; i < 16; ++i) { O[0][i] *= alpha; O[1][i] *= alpha; }
    }
    float rs = 0.f;
#pragma unroll
    for (int r = 0; r < 16; ++r) { S0[r] = fexp2(S0[r] - m); S1[r] = fexp2(S1[r] - m); rs += S0[r] + S1[r]; }
    rs = xhalf_sum(rs);
    lsum += rs;
#pragma unroll
    for (int sp = 0; sp < 2; ++sp) {
        const bf16x8 p0 = PACK8(S0, sp), p1 = PACK8(S1, sp);
#pragma unroll
        for (int dh = 0; dh < 2; ++dh) {
            LAS unsigned char* vp0 = VT + (16 * sp + 4 * hi + qq) * 192 + (32 * dh + 16 * blk + 4 * p) * 2;
            const bf16x8 vf0 = cat8(tr_read(vp0), tr_read(vp0 + 8 * 192));
            O[dh] = MFMA32(vf0, p0, O[dh]);
            LAS unsigned char* vp1 = vp0 + 32 * 192;
            const bf16x8 vf1 = cat8(tr_read(vp1), tr_read(vp1 + 8 * 192));
            O[dh] = MFMA32(vf1, p1, O[dh]);
        }
    }
}

__device__ __forceinline__ void attn_load(u32x4& kv, u32x4& vv, const bf16_t* base, int kcol, int vcol, int tid) {
    const unsigned loff = (unsigned)((tid >> 3) * 768 + 8 * (tid & 7)) * 2u;
    kv = *(const u32x4*)((const char*)(base + kcol) + loff);
    vv = *(const u32x4*)((const char*)(base + vcol) + loff);
}
__device__ __forceinline__ void attn_store(LAS unsigned char* KT, LAS unsigned char* VT, const u32x4& kv, const u32x4& vv, int tid) {
    const int key = tid >> 3, chk = tid & 7;
    *(LAS u32x4*)(KT + key * 144 + chk * 16) = kv;
    *(LAS u32x4*)(VT + key * 192 + chk * 16) = vv;
}

__device__ __forceinline__ int next_tile(unsigned& rem) { if (!rem) return -1; const int j = __builtin_ctz(rem); rem &= rem - 1u; return j; }
template <int MODE>
__device__ __forceinline__ void attn_pass(LAS unsigned char* lds, const bf16_t* KVb, int kcol, int vcol, unsigned rem, unsigned mysel, int qt, int s,
                                          const bf16x8 (&qf)[4], float& m, float& lsum, f32x16 (&O)[2], int tid, int lane) {
    u32x4 ak, av, bk, bv;
    int j = next_tile(rem), j1 = next_tile(rem), j2 = next_tile(rem);
    attn_load(ak, av, KVb + (size_t)(64 * j) * 768, kcol, vcol, tid);
    if (j1 >= 0) attn_load(bk, bv, KVb + (size_t)(64 * j1) * 768, kcol, vcol, tid);
    __syncthreads();
    attn_store(lds + AT_KT, lds + AT_VT, ak, av, tid);
    if (j2 >= 0) attn_load(ak, av, KVb + (size_t)(64 * j2) * 768, kcol, vcol, tid);
#define ATT_STEP(CB, NB, RK, RV) { \
        __syncthreads();                   \
        const int j3 = next_tile(rem); \
        if (j1 >= 0) { attn_store(lds + (NB), lds + (NB) + 9216, RK, RV, tid); if (j3 >= 0) attn_load(RK, RV, KVb + (size_t)(64 * j3) * 768, kcol, vcol, tid); } \
        if (MODE == 1) { const bool mine = (mysel >> j) & 1u; const unsigned long long bm = __ballot(mine); \
            if (bm != 0ull) attn_tile<1>(lds + (CB), lds + (CB) + 9216, qf, m, lsum, O, lane, s - 64 * j, mine, (bm != ~0ull) || (j == qt)); } \
        else attn_tile<2>(lds + (CB), lds + (CB) + 9216, qf, m, lsum, O, lane, s - 64 * j, true, (j == qt) || (j == qt - 8)); \
        if (j1 < 0) break; \
        j = j1; j1 = j2; j2 = j3; }
    for (;;) {
        ATT_STEP(AT_KT, AT_BUF2, bk, bv)
        ATT_STEP(AT_BUF2, AT_KT, ak, av)
    }
#undef ATT_STEP
}

__device__ __forceinline__ void attn_unit(CArgsP a, LAS unsigned char* lds, int b, int g, int qt, int tid, int wave, int lane) {
    LAS unsigned char* KT = lds + AT_KT; LAS unsigned char* VT = lds + AT_VT; LAS unsigned char* KCs = lds + AT_KC; LAS unsigned char* VCs = lds + AT_VC;
    LAS float* IMP4 = (LAS float*)(lds + AT_IMP4); LAS float* IMPF = (LAS float*)(lds + AT_IMPF); LAS unsigned* SELM = (LAS unsigned*)(lds + AT_SELM);
    const bf16_t* QR = (const bf16_t*)(a->ws + WS_QR); const bf16_t* KV = (const bf16_t*)(a->ws + WS_KV);
    const bf16_t* KCg = (const bf16_t*)(a->ws + WS_KC) + (size_t)(b * 2 + g) * 128 * 64; const bf16_t* VCg = (const bf16_t*)(a->ws + WS_VC) + (size_t)(b * 2 + g) * 128 * 64;
    const float* GATES = (const float*)(a->ws + WS_GATES); bf16_t* YA = (bf16_t*)(a->ws + WS_YA);
    const int hh = wave >> 1, qh = wave & 1, q = lane & 31, hi = lane >> 5, blk = (lane >> 4) & 1, qq = (lane & 15) >> 2, p = lane & 3;
    const int s = qt * 64 + qh * 32 + q, head = g * 4 + hh;
    const int row = b * 2048 + s;
#pragma unroll
    for (int i = 0; i < 2; ++i) {
        const int idx = tid + 512 * i, r = idx >> 3, c = idx & 7;
        *(LAS u32x4*)(KCs + r * 144 + c * 16) = *(const u32x4*)(KCg + r * 64 + c * 8);
        *(LAS u32x4*)(VCs + r * 192 + c * 16) = *(const u32x4*)(VCg + r * 64 + c * 8);
    }
    bf16x8 qf[4];
#pragma unroll
    for (int c = 0; c < 4; ++c) qf[c] = *(const bf16x8*)(QR + (size_t)row * 512 + head * 64 + 16 * c + 8 * hi);
    __syncthreads();
    f32x16 oacc[2];
    {
        f32x16 S[4];
#pragma unroll
        for (int kb = 0; kb < 4; ++kb) {
#pragma unroll
            for (int i = 0; i < 16; ++i) S[kb][i] = 0.f;
#pragma unroll
            for (int c = 0; c < 4; ++c) { const bf16x8 kf = *(const LAS bf16x8*)(KCs + (32 * kb + q) * 144 + (16 * c + 8 * hi) * 2); S[kb] = MFMA32(kf, qf[c], S[kb]); }
        }
        const int nlim = (s - 31) >> 4;
        float mx = -1e30f;
#pragma unroll
        for (int kb = 0; kb < 4; ++kb)
#pragma unroll
            for (int r = 0; r < 16; ++r) { const int n = 32 * kb + crow(r, hi); S[kb][r] = (n <= nlim) ? S[kb][r] : -1e30f; mx = fmaxf(mx, S[kb][r]); }
        mx = xhalf_max(mx);
        float sum = 0.f;
#pragma unroll
        for (int kb = 0; kb < 4; ++kb)
#pragma unroll
            for (int r = 0; r < 16; ++r) { S[kb][r] = fexp2(S[kb][r] - mx); sum += S[kb][r]; }
        sum = xhalf_sum(sum);
        const float inv = (s >= 31) ? 1.f / sum : 0.f;
        float prevX = 0.f;
        LAS float* impw = IMP4 + (hh * 64 + qh * 32 + q) * 33;
#pragma unroll
        for (int kb = 0; kb < 4; ++kb) {
#pragma unroll
            for (int r = 0; r < 16; ++r) S[kb][r] *= inv;
#pragma unroll
            for (int rr = 0; rr < 4; ++rr) {
                const float E = 0.5f * S[kb][4 * rr + 3];
                const float T = S[kb][4 * rr] + S[kb][4 * rr + 1] + S[kb][4 * rr + 2] + E;
                const float X = xhalf_other(E, hi);
                impw[8 * kb + 2 * rr + hi] = T + (hi ? X : prevX);
                prevX = X;
            }
        }
        f32x16 O[2];
#pragma unroll
        for (int i = 0; i < 16; ++i) { O[0][i] = 0.f; O[1][i] = 0.f; }
#pragma unroll
        for (int kb = 0; kb < 4; ++kb)
#pragma unroll
            for (int sp = 0; sp < 2; ++sp) {
                const bf16x8 pf = PACK8(S[kb], sp);
#pragma unroll
                for (int dh = 0; dh < 2; ++dh) {
                    LAS unsigned char* vp = VCs + (32 * kb + 16 * sp + 4 * hi + qq) * 192 + (32 * dh + 16 * blk + 4 * p) * 2;
                    const bf16x8 vf = cat8(tr_read(vp), tr_read(vp + 8 * 192));
                    O[dh] = MFMA32(vf, pf, O[dh]);
                }
            }
        const float g0 = GATES[(size_t)row * 24 + head * 3 + 0];
#pragma unroll
        for (int i = 0; i < 16; ++i) { oacc[0][i] = g0 * O[0][i]; oacc[1][i] = g0 * O[1][i]; }
    }
    __syncthreads();
    {
        const int qi = tid >> 3, jb = tid & 7;
        float v[4];
#pragma unroll
        for (int jj = 0; jj < 4; ++jj) {
            const int j = 4 * jb + jj;
            float t = IMP4[(0 * 64 + qi) * 33 + j] + IMP4[(1 * 64 + qi) * 33 + j] + IMP4[(2 * 64 + qi) * 33 + j] + IMP4[(3 * 64 + qi) * 33 + j];
            const bool forced = (j == 0) || (j == qt) || (j == qt - 1), valid = j <= qt;
            t = forced ? 1e4f : (valid ? t : -1e4f);
            v[jj] = t; IMPF[qi * 33 + j] = t;
        }
        __syncthreads();
        unsigned bits = 0u;
#pragma unroll
        for (int jj = 0; jj < 4; ++jj) {
            const int j = 4 * jb + jj; int cnt = 0;
            for (int k = 0; k < 32; ++k) { const float w = IMPF[qi * 33 + k]; cnt += (w > v[jj] || (w == v[jj] && k < j)) ? 1 : 0; }
            bits |= (cnt < 16 ? 1u : 0u) << j;
        }
        bits |= __shfl_xor(bits, 1); bits |= __shfl_xor(bits, 2); bits |= __shfl_xor(bits, 4);
        if (jb == 0) SELM[qi] = bits;
        __syncthreads();
        if (tid < 64) {
            unsigned un = SELM[tid];
#pragma unroll
            for (int o = 1; o < 64; o <<= 1) un |= __shfl_xor(un, o);
            if (tid == 0) SELM[64] = un;
        }
        __syncthreads();
    }
    const unsigned mysel = SELM[qh * 32 + q], uni = SELM[64];
    const bf16_t* KVb = KV + (size_t)b * 2048 * 768;
    LAS float* stash = (LAS float*)(lds + AT_KC + wave * 8192) + lane;
#pragma unroll
    for (int i = 0; i < 16; ++i) { stash[i * 64] = oacc[0][i]; stash[(16 + i) * 64] = oacc[1][i]; }
    {
        float m = 0.f, lsum = 0.f; f32x16 O[2];
#pragma unroll
        for (int i = 0; i < 16; ++i) { O[0][i] = 0.f; O[1][i] = 0.f; }
        const unsigned rem = uni & (qt == 31 ? 0xffffffffu : ((2u << qt) - 1u));
        attn_pass<1>(lds, KVb, (4 + g) * 64, (6 + g) * 64, rem, mysel, qt, s, qf, m, lsum, O, tid, lane);
        const float sc = GATES[(size_t)row * 24 + head * 3 + 1] / lsum;
#pragma unroll
        for (int i = 0; i < 16; ++i) { stash[i * 64] += sc * O[0][i]; stash[(16 + i) * 64] += sc * O[1][i]; }
    }
    {
        float m = 0.f, lsum = 0.f; f32x16 O[2];
#pragma unroll
        for (int i = 0; i < 16; ++i) { O[0][i] = 0.f; O[1][i] = 0.f; }
        const unsigned all = (qt == 31 ? 0xffffffffu : ((2u << qt) - 1u)), lo = (qt > 8) ? ((1u << (qt - 8)) - 1u) : 0u;
        attn_pass<2>(lds, KVb, (8 + g) * 64, (10 + g) * 64, all & ~lo, 0u, qt, s, qf, m, lsum, O, tid, lane);
        const float sc = GATES[(size_t)row * 24 + head * 3 + 2] / lsum;
#pragma unroll
        for (int i = 0; i < 16; ++i) { oacc[0][i] = stash[i * 64] + sc * O[0][i]; oacc[1][i] = stash[(16 + i) * 64] + sc * O[1][i]; }
    }
#pragma unroll
    for (int dh = 0; dh < 2; ++dh)
#pragma unroll
        for (int rr = 0; rr < 4; ++rr) {
            u32x2 w; w.x = pk2(oacc[dh][4 * rr], oacc[dh][4 * rr + 1]); w.y = pk2(oacc[dh][4 * rr + 2], oacc[dh][4 * rr + 3]);
            *(u32x2*)(YA + (size_t)row * 512 + head * 64 + 32 * dh + 8 * rr + 4 * hi) = w;
        }
    __syncthreads();
}

struct PanelNormOrder : pg8::StaticOrder {
    unsigned* cnt; const unsigned* xtab; LAS unsigned char* lds; const float* h; float* fout; bf16_t* XN; const float* modp; const float* adab; const float* gvec; int l, i, fin, tid;
    __device__ __forceinline__ void done(const pg8::Unit& u) const {
        const int wave = __builtin_amdgcn_readfirstlane(tid >> 6), lane = tid & 63;
        LAS float* SH = (LAS float*)(lds + 131072 + 1024);
        asm volatile("s_waitcnt vmcnt(0)" ::: "memory");
        __syncthreads();
        if (tid == 0) {
            const unsigned* xt = xtab + u.pm * 4; const unsigned my = xb_xcc_id() + 1u;
            const bool same_l2 = (xt[0] == my) & (xt[1] == my) & (xt[2] == my) & (xt[3] == my);
            if (!same_l2) { __builtin_amdgcn_fence(__ATOMIC_RELEASE, "agent"); asm volatile("s_waitcnt vmcnt(0)" ::: "memory"); }
            unsigned* c = cnt + 16 * u.pm;
            __hip_atomic_fetch_add(c, 1u, __ATOMIC_RELAXED, __HIP_MEMORY_SCOPE_AGENT);
            unsigned sp = 0;
            while (__hip_atomic_load(c, __ATOMIC_RELAXED, __HIP_MEMORY_SCOPE_AGENT) < 4u) { __builtin_amdgcn_s_sleep(1); if (++sp > (1u << 22)) break; }
            __builtin_amdgcn_fence(__ATOMIC_ACQUIRE, "agent");
            asm volatile("s_waitcnt vmcnt(0)" ::: "memory");
        }
        __syncthreads();
        const int b = u.pm >> 3, r0 = u.pm * 256 + u.pn * 64;
        if (!fin) {
            const int which = tid >> 8, c4 = 4 * (tid & 255);
            f32x4 v = modv4(modp, adab, l, b, (i * 3 + which) * 1024 + c4);
            if (which) v += 1.f;
            *(LAS f32x4*)(SH + which * 1024 + c4) = v;
            __syncthreads();
        }
        for (int rb = 0; rb < 2; ++rb) {
            f32x4 v[4][4];
#pragma unroll
            for (int r4 = 0; r4 < 4; ++r4) {
                const f32x4* xr = (const f32x4*)(h + (size_t)(r0 + wave * 8 + rb * 4 + r4) * 1024) + lane;
#pragma unroll
                for (int j = 0; j < 4; ++j) v[r4][j] = xr[64 * j];
            }
#pragma unroll
            for (int r4 = 0; r4 < 4; ++r4) {
                const int row = r0 + wave * 8 + rb * 4 + r4;
                float ss = 0.f;
#pragma unroll
                for (int j = 0; j < 4; ++j) ss += (v[r4][j].x * v[r4][j].x + v[r4][j].y * v[r4][j].y) + (v[r4][j].z * v[r4][j].z + v[r4][j].w * v[r4][j].w);
                const float rstd = rsqrtf(wave_sum(ss) * (1.f / 1024.f) + 1e-6f);
#pragma unroll
                for (int j = 0; j < 4; ++j) {
                    const int col = 4 * lane + 256 * j;
                    const f32x4 g4 = *(const f32x4*)(gvec + col);
                    if (fin) { *((f32x4*)(fout + (size_t)row * 1024) + lane + 64 * j) = (v[r4][j] * rstd) * g4; }
                    else {
                        const f32x4 sh = *(const LAS f32x4*)(SH + col), sc = *(const LAS f32x4*)(SH + 1024 + col);
                        const f32x4 o = (v[r4][j] * rstd) * g4 * sc + sh;
                        u32x2 w; w.x = pk2(o.x, o.y); w.y = pk2(o.z, o.w);
                        *(u32x2*)(XN + (size_t)row * 1024 + col) = w;
                    }
                }
            }
        }
    }
};

#define XB_TMO      128
#define XB_XCNT(j)  (256  + 64 * (j))
#define XB_XSUB(j)  (1280 + 64 * (j))
#define XB_XGEN(j)  (2304 + 64 * (j))
#define XB_TOP      3328
#define XB_TOPGEN   3392
#define XCD_BAR_WORDS 3456
#define XB_SPIN_CAP (1u << 18)

__device__ __forceinline__ unsigned xb_ld(unsigned* p)              { return __hip_atomic_load(p, __ATOMIC_RELAXED, __HIP_MEMORY_SCOPE_AGENT); }
__device__ __forceinline__ unsigned xb_add(unsigned* p, unsigned v) { return __hip_atomic_fetch_add(p, v, __ATOMIC_RELAXED, __HIP_MEMORY_SCOPE_AGENT); }
__device__ __forceinline__ unsigned xb_xcc_id() { return (unsigned)__builtin_amdgcn_s_getreg((3 << 11) | 20) & 0xFu; }
#define XB_SPIN(cond, bar) do { unsigned _sp = 0; while (cond) { __builtin_amdgcn_s_sleep(1); \
    if ((++_sp & 255u) == 0u) { if (xb_ld(&(bar)[XB_TMO])) break; if (_sp > XB_SPIN_CAP) { atomicAdd(&(bar)[XB_TMO], 1u); break; } } } } while (0)

struct XcdBarrier {
    unsigned* bar; unsigned x;
    volatile LAS unsigned* st;
};

__device__ __forceinline__ XcdBarrier xcd_barrier_post(unsigned* bar, volatile LAS unsigned* st) {
    XcdBarrier b; b.bar = bar; b.x = xb_xcc_id(); b.st = st;
    if (threadIdx.x == 0) (void)xb_add(&bar[XB_XCNT(b.x)], 1u);
    return b;
}
__device__ __forceinline__ void xcd_barrier_complete(unsigned* bar, unsigned x, unsigned& nloc, unsigned& nx) {
    const unsigned G = gridDim.x * gridDim.y * gridDim.z;
    unsigned sum, cnt, mine, sp = 0u;
    for (;;) {
        sum = 0u; cnt = 0u; mine = 0u;
#pragma unroll
        for (unsigned j = 0; j < 16; ++j) { const unsigned c = xb_ld(&bar[XB_XCNT(j)]); sum += c; cnt += (c > 0u) ? 1u : 0u; mine = (j == x) ? c : mine; }
        if (sum == G) break;
        __builtin_amdgcn_s_sleep(1);
        if ((++sp & 255u) == 0u) { if (xb_ld(&bar[XB_TMO])) break; if (sp > XB_SPIN_CAP) { atomicAdd(&bar[XB_TMO], 1u); break; } }
    }
    nloc = mine > 0u ? mine : 1u; nx = cnt > 0u ? cnt : 1u;
}

__device__ __forceinline__ void xcd_barrier(const XcdBarrier& b) {
    asm volatile("s_waitcnt vmcnt(0)" ::: "memory");
    __syncthreads();
    if (threadIdx.x == 0) {
        unsigned* bar = b.bar;
        __builtin_amdgcn_s_waitcnt(0);
        unsigned nloc = b.st[0], nx = b.st[1];
        if (nloc == 0u) { xcd_barrier_complete(bar, b.x, nloc, nx); b.st[0] = nloc; b.st[1] = nx; }
        const unsigned old = xb_add(&bar[XB_XSUB(b.x)], 1u);
        const unsigned gen = old / nloc;
        if (old + 1u == (gen + 1u) * nloc) {
            __builtin_amdgcn_fence(__ATOMIC_RELEASE, "agent");
            asm volatile("s_waitcnt vmcnt(0)" ::: "memory");
            const unsigned og = xb_add(&bar[XB_TOP], 1u);
            const unsigned tg = og / nx;
            if (og + 1u == (tg + 1u) * nx) xb_add(&bar[XB_TOPGEN], 1u);
            else XB_SPIN(xb_ld(&bar[XB_TOPGEN]) == tg, bar);
            __builtin_amdgcn_fence(__ATOMIC_ACQUIRE, "agent");
            xb_add(&bar[XB_XGEN(b.x)], 1u);
            asm volatile("s_waitcnt vmcnt(0)" ::: "memory");
        } else {
            XB_SPIN(xb_ld(&bar[XB_XGEN(b.x)]) == gen, bar);
            __builtin_amdgcn_fence(__ATOMIC_ACQUIRE, "agent");
            asm volatile("s_waitcnt vmcnt(0)" ::: "memory");
        }
    }
    __syncthreads();
}

#define GRID_BAR() do { XcdBarrier xb_; xb_.bar = (unsigned*)(a->ws + WS_BAR); xb_.x = xb_xcc_id(); xb_.st = (volatile LAS unsigned*)(lds + 131072 + 256); xcd_barrier(xb_); } while (0)
template <int ph> __device__ __forceinline__ void phase_work(LAS unsigned char* lds, const int wave_in) {
        CArgsP a = (CArgsP)__builtin_amdgcn_kernarg_segment_ptr();
        int wave = wave_in, G = gridDim.x, bid = blockIdx.x;
        asm volatile("" : "+s"(a), "+s"(wave), "+s"(G), "+s"(bid));
        int lane = __builtin_amdgcn_mbcnt_hi(~0u, __builtin_amdgcn_mbcnt_lo(~0u, 0u));
        asm volatile("" : "+v"(lane));
        const int tid = wave * 64 + lane;
        if constexpr (ph == 0) { if (EN & 1) phase_prologue(a, lds, tid, wave, lane); }
        else if constexpr (ph == N_PHASES - 1) phase_final_norm(a, wave, lane);
        else {
            constexpr int l = (ph - 1) / 12, sub = (ph - 1) % 12;
            const float* hcur = (l == 0 && sub <= 2) ? a->in[0] : a->out;
            const float* modp = (const float*)(a->ws + WS_MODP); const float* adab = a->in[3];
            if constexpr ((EN & 2) && (sub == 0 || sub == 3 || sub == 9)) {
                phase_norm(a, lds, hcur, l, sub == 0 ? 0 : (sub == 3 ? 1 : 2), tid, wave, lane);
            } else if constexpr ((EN & 4) && (sub == 1 || sub == 10)) {
                const int w = l * 2 + (sub == 10 ? 1 : 0);
                pg8::Gemm gm{(const pg8::bf16_t*)(a->ws + WS_XN), (const pg8::bf16_t*)(a->ws + WS_WFI) + (size_t)w * NFF2 * 1024, MROWS, NFF2, 1024, 0, 1};
                pg8::StaticOrder S; S.init(MROWS, NFF2, G, bid);
                EpiSwiglu E{(bf16_t*)(a->ws + WS_HID)};
                pg8::gemm_phase<EpiSwiglu, pg8::StaticOrder, true, true>(lds, gm, S, E, tid);
                if constexpr (BG_PREP && l == 0) bg_prep(a, lds, (MROWS / 256) * (NFF2 / 256), sub == 1 ? 0 : 2, G, bid, tid, wave, lane);
            } else if constexpr ((EN & 8) && (sub == 2 || sub == 11)) {
                const int w = l * 2 + (sub == 11 ? 1 : 0);
                pg8::Gemm gm{(const pg8::bf16_t*)(a->ws + WS_HID), (const pg8::bf16_t*)(a->ws + WS_WFO) + (size_t)w * 1024 * DFF, MROWS, 1024, DFF, 1, 1};
                EpiResid E{hcur, a->out, modp, adab, l, (sub == 2 ? 2 : 8) * 1024, 0.5f};
                if constexpr (FUSE_NORM) {
                    const int fin = (sub == 11 && l == 1) ? 1 : 0, nl = (sub == 11) ? l + 1 : l, ni = (sub == 2) ? 1 : 0;
                    PanelNormOrder S; S.init(MROWS, 1024, G, bid);
                    S.cnt = (unsigned*)(a->ws + WS_CNT) + (l * 3 + (sub == 2 ? 0 : 2)) * 1024; S.xtab = (const unsigned*)(a->ws + WS_XT); S.lds = lds; S.h = a->out; S.fout = a->out; S.XN = (bf16_t*)(a->ws + WS_XN);
                    S.modp = modp; S.adab = adab; S.gvec = fin ? a->in[18] : a->in[4] + (nl * 3 + ni) * 1024; S.l = nl; S.i = ni; S.fin = fin; S.tid = tid;
                    pg8::gemm_phase<EpiResid, PanelNormOrder, true, true>(lds, gm, S, E, tid);
                } else {
                    pg8::StaticOrder S; S.init(MROWS, 1024, G, bid);
                    pg8::gemm_phase<EpiResid, pg8::StaticOrder, true, true>(lds, gm, S, E, tid);
                }
            } else if constexpr ((EN & 16) && sub == 4) {
                pg8::Gemm gm{(const pg8::bf16_t*)(a->ws + WS_XN), (const pg8::bf16_t*)(a->ws + WS_WMIX) + (size_t)l * NINP * 1024, MROWS, NINP, 1024, 0, 1};
                pg8::StaticOrder S; S.init(MROWS, NINP, G, bid);
                const float* rc = (const float*)(a->ws + WS_ROPE);
                EpiMix E{(bf16_t*)(a->ws + WS_QR), (bf16_t*)(a->ws + WS_KV), (bf16_t*)(a->ws + WS_EW), (float*)(a->ws + WS_GATES), rc, rc + 65536};
                pg8::gemm_phase<EpiMix, pg8::StaticOrder, true, true>(lds, gm, S, E, tid);
                if constexpr (BG_PREP && l == 0) bg_prep(a, lds, (MROWS / 256) * (NINP / 256), 1, G, bid, tid, wave, lane);
            } else if constexpr ((EN & 32) && sub == 5) {
                for (int u = bid; u < 512; u += G) {
                    if (u < 256) compress_unit(a, lds, l, u, tid, wave, lane);
                    else gmlp_unit(a, lds, l, u - 256, tid, wave, lane);
                }
            } else if constexpr ((EN & 64) && sub == 6) {
                for (int u = bid; u < 512; u += G) {
                    const int bg = u & 15, k = (u >> 4) & 15, qt = (u < 256) ? 31 - k : k;
                    attn_unit(a, lds, bg >> 1, bg & 1, qt, tid, wave, lane);
                }
            } else if constexpr ((EN & 128) && sub == 7) {
                pg8::StaticOrder S; S.init(MROWS, 1024, G, bid);
                { pg8::Gemm gm{(const pg8::bf16_t*)(a->ws + WS_YA), (const pg8::bf16_t*)(a->ws + WS_WPA) + (size_t)l * 1024 * 512, MROWS, 1024, 512, 0, 1};
                  EpiProj<0> E{(const bf16_t*)(a->ws + WS_EW), (bf16_t*)(a->ws + WS_MG)};
                  pg8::gemm_phase<EpiProj<0>, pg8::StaticOrder, true, true>(lds, gm, S, E, tid); }
                { pg8::Gemm gm{(const pg8::bf16_t*)(a->ws + WS_YB), (const pg8::bf16_t*)(a->ws + WS_WPB) + (size_t)l * 1024 * 512, MROWS, 1024, 512, 0, 1};
                  EpiProj<1> E{(const bf16_t*)(a->ws + WS_EW), (bf16_t*)(a->ws + WS_MG)};
                  pg8::gemm_phase<EpiProj<1>, pg8::StaticOrder, true, true>(lds, gm, S, E, tid); }
            } else if constexpr ((EN & 256) && sub == 8) {
                pg8::Gemm gm{(const pg8::bf16_t*)(a->ws + WS_MG), (const pg8::bf16_t*)(a->ws + WS_WO) + (size_t)l * 1024 * 1024, MROWS, 1024, 1024, 0, 1};
                EpiResid E{a->out, a->out, modp, adab, l, 5 * 1024, 1.0f};
                if constexpr (FUSE_NORM) {
                    PanelNormOrder S; S.init(MROWS, 1024, G, bid);
                    S.cnt = (unsigned*)(a->ws + WS_CNT) + (l * 3 + 1) * 1024; S.xtab = (const unsigned*)(a->ws + WS_XT); S.lds = lds; S.h = a->out; S.fout = a->out; S.XN = (bf16_t*)(a->ws + WS_XN);
                    S.modp = modp; S.adab = adab; S.gvec = a->in[4] + (l * 3 + 2) * 1024; S.l = l; S.i = 2; S.fin = 0; S.tid = tid;
                    pg8::gemm_phase<EpiResid, PanelNormOrder, true, true>(lds, gm, S, E, tid);
                } else {
                    pg8::StaticOrder S; S.init(MROWS, 1024, G, bid);
                    pg8::gemm_phase<EpiResid, pg8::StaticOrder, true, true>(lds, gm, S, E, tid);
                }
            }
        }
}
template <int ph> __device__ __forceinline__ void run_phase(LAS unsigned char* lds, cg::grid_group& grid, const int wave_in) {
    constexpr bool fused_away = FUSE_NORM && (ph == N_PHASES - 1 || (ph >= 1 && ((ph - 1) % 12 == 3 || (ph - 1) % 12 == 9 || ph == 13)));
    if constexpr (!fused_away) {
        CArgsP a = (CArgsP)__builtin_amdgcn_kernarg_segment_ptr();
        phase_work<ph>(lds, wave_in);
        constexpr bool again = (PROBE_REP && ph >= 1 && ph < N_PHASES - 1 && ((PROBE_REP >> ((ph - 1) % 12)) & 1)) || (ph == 0 && (PROBE_REP & 4096)) || (ph == 3 && (PROBE_REP & 8192));
        if constexpr (again) { GRID_BAR(); phase_work<ph>(lds, wave_in); }
        if constexpr (PROBE_SYNC >= 1) GRID_BAR();
        if constexpr (PROBE_SYNC >= 2) GRID_BAR();
        if constexpr (ph + 1 < N_PHASES - (FUSE_NORM ? 1 : 0)) { if constexpr (ph == 0) { if (a->ph_hi == 12345) grid.sync(); } GRID_BAR(); }
    }
}
__global__ void __launch_bounds__(NTHR, 2) fwd_kernel(Args a_by_value) {
    CArgsP a = (CArgsP)__builtin_amdgcn_kernarg_segment_ptr();
    extern __shared__ __attribute__((aligned(16))) unsigned char lds_raw[];
    LAS unsigned char* lds = (LAS unsigned char*)lds_raw;
    cg::grid_group grid = cg::this_grid();
    volatile LAS unsigned* bst = (volatile LAS unsigned*)(lds + 131072 + 256);
    if (threadIdx.x < 2) bst[threadIdx.x] = 0u;
    __syncthreads();
    (void)xcd_barrier_post((unsigned*)(a->ws + WS_BAR), bst);
    const int wv = __builtin_amdgcn_readfirstlane(threadIdx.x >> 6);
    run_phase<0>(lds, grid, wv); run_phase<1>(lds, grid, wv); run_phase<2>(lds, grid, wv); run_phase<3>(lds, grid, wv); run_phase<4>(lds, grid, wv); run_phase<5>(lds, grid, wv); run_phase<6>(lds, grid, wv);
    run_phase<7>(lds, grid, wv); run_phase<8>(lds, grid, wv); run_phase<9>(lds, grid, wv); run_phase<10>(lds, grid, wv); run_phase<11>(lds, grid, wv); run_phase<12>(lds, grid, wv); run_phase<13>(lds, grid, wv);
    run_phase<14>(lds, grid, wv); run_phase<15>(lds, grid, wv); run_phase<16>(lds, grid, wv); run_phase<17>(lds, grid, wv); run_phase<18>(lds, grid, wv); run_phase<19>(lds, grid, wv); run_phase<20>(lds, grid, wv);
    run_phase<21>(lds, grid, wv); run_phase<22>(lds, grid, wv); run_phase<23>(lds, grid, wv); run_phase<24>(lds, grid, wv); run_phase<25>(lds, grid, wv);
}

extern "C" void kernel_launch(void* const* d_in, const int* in_sizes, int n_in, void* d_out, int out_size, void* d_ws, size_t ws_size, hipStream_t stream) {
    static int grid = 0;
    if (grid == 0) {
        if (n_in != 19 || out_size != MROWS * DM || ws_size < WS_END) { fprintf(stderr, "kernel_launch: unexpected shapes (n_in %d out %d ws %zu)\n", n_in, out_size, ws_size); grid = -1; return; }
        int dev = 0, cus = 0, per_cu = 0;
        hipGetDevice(&dev);
        hipDeviceGetAttribute(&cus, hipDeviceAttributeMultiprocessorCount, dev);
        if (hipFuncSetAttribute((const void*)fwd_kernel, hipFuncAttributeMaxDynamicSharedMemorySize, LDS_BYTES) != hipSuccess) { fprintf(stderr, "kernel_launch: hipFuncSetAttribute failed\n"); grid = -1; return; }
        if (hipOccupancyMaxActiveBlocksPerMultiprocessor(&per_cu, (const void*)fwd_kernel, NTHR, LDS_BYTES) != hipSuccess || per_cu < 1) { fprintf(stderr, "kernel_launch: occupancy query gave %d\n", per_cu); per_cu = 1; }
        (void)hipGetLastError();
        grid = cus * 1;
        if (grid > 256) grid = 256;
    }
    if (grid < 0) return;
    if (hipMemsetAsync((char*)d_ws + WS_BAR, 0, 16384 + 6 * 1024 * 4, stream) != hipSuccess) { fprintf(stderr, "kernel_launch: memset failed\n"); return; }
    Args a{};
    for (int i = 0; i < 19; ++i) a.in[i] = (const float*)d_in[i];
    a.out = (float*)d_out; a.ws = (unsigned char*)d_ws; a.ph_lo = 0; a.ph_hi = N_PHASES;
    void* args[] = {&a};
    hipError_t e = hipLaunchCooperativeKernel((const void*)fwd_kernel, dim3(grid), dim3(NTHR), args, LDS_BYTES, stream);
    if (e != hipSuccess) fprintf(stderr, "cooperative launch failed: %s (grid %d)\n", hipGetErrorString(e), grid);
}
```

```cpp
#include <hip/hip_runtime.h>
#include <hip/hip_cooperative_groups.h>
#include <cstdio>
#include <cstdint>
namespace cg = cooperative_groups;
namespace pg8 {
#define PG8_LAS __attribute__((address_space(3)))
typedef unsigned short bf16_t;
typedef short bf16x8 __attribute__((ext_vector_type(8)));
typedef float f32x4 __attribute__((ext_vector_type(4)));
typedef unsigned u32x4 __attribute__((ext_vector_type(4)));
constexpr int BM = 256, BK = 64, HALF = 128, HTB = HALF * BK * 2  , STAGE_BYTES = 8 * HTB, NXCD = 8, WGM = 4;

__host__ __device__ __forceinline__ int lds_byte(int r, int c) { const int st = (r >> 4) * 2 + (c >> 5), rr = r & 15, cc = c & 31, ob = rr * 64 + cc * 2; return st * 1024 + (ob ^ (((ob >> 9) & 1) << 5)); }
__host__ __device__ __forceinline__ void stage_rc(int b, int& R, int& C) { const int st = b / 1024, sb = b % 1024, swz = sb ^ (((sb >> 9) & 1) << 5); R = (st >> 1) * 16 + swz / 64; C = (st & 1) * 32 + (swz % 64) / 2; }
__host__ __device__ __forceinline__ int perm32(int rho) { const int n = rho >> 4, i = rho & 15; return 8 * (i >> 2) + 4 * n + (i & 3); }

struct Unit { int pm, pn; };
struct Gemm { const bf16_t* A; const bf16_t* Bt; int M, N, K; int a_tiled, b_tiled; };

struct StaticOrder {
    int nM, nN, nwg, G, c;
    __host__ __device__ void init(int M, int N, int G_, int c_) { nM = M / BM; nN = N / BM; nwg = nM * nN; G = G_; c = c_; }
    __host__ __device__ bool next(int i, Unit& u) const {
        const long L = (long)i * G + c; if (L >= nwg) return false;
        int wgid = (int)L; { const int q = nwg / NXCD, r = nwg % NXCD, xcd = wgid % NXCD, off = wgid / NXCD; wgid = (xcd < r ? xcd * (q + 1) : r * (q + 1) + (xcd - r) * q) + off; }
        const int nig = WGM * nN, gid = wgid / nig, fm = gid * WGM, gsz = (nM - fm) < WGM ? (nM - fm) : WGM;
        u.pm = fm + ((wgid % nig) % gsz); u.pn = (wgid % nig) / gsz; return true;
    }
    __device__ __forceinline__ void a_ready(const Unit&) const {}
    __device__ __forceinline__ void done(const Unit&) const {}
};

__device__ __forceinline__ unsigned cvt_pk_bf16(float lo, float hi) { unsigned r; asm volatile("v_cvt_pk_bf16_f32 %0, %1, %2" : "=v"(r) : "v"(lo), "v"(hi)); return r; }
template <class Epi, class Sched, bool ALIGN_EPI = false, bool SP2 = false>
__device__ __forceinline__ void gemm_phase(PG8_LAS unsigned char* lds, const Gemm g, const Sched& S, const Epi& E, const int tid_in) {
    const int tid = tid_in, wid = __builtin_amdgcn_readfirstlane(tid >> 6), lane = tid & 63, wr = wid >> 2, wc = wid & 3, fr = lane & 15, fq = lane >> 4;
    const int K = g.K, nt = K / BK;
    unsigned voffA[2], voffB[2];
#pragma unroll
    for (int i = 0; i < 2; ++i) { int R, C; stage_rc(tid * 16 + i * 8192, R, C); const int Rb = Epi::PERM ? ((R & ~31) + perm32(R & 31)) : R;
        voffA[i] = (unsigned)(R * (g.a_tiled ? BK : K) + C) * 2u; voffB[i] = (unsigned)(Rb * (g.b_tiled ? BK : K) + C) * 2u; }
    const size_t kstep = (size_t)(BK * 2);
    const size_t hstep = (size_t)HALF * K * 2;
    const size_t tstep = 2 * hstep;
    const size_t kstepA = g.a_tiled ? (size_t)BM * BK * 2 : kstep, hstepA = g.a_tiled ? (size_t)HALF * BK * 2 : hstep, tstepA = g.a_tiled ? (size_t)(K / BK) * BM * BK * 2 : tstep;
    const size_t kstepB = g.b_tiled ? (size_t)BM * BK * 2 : kstep, hstepB = g.b_tiled ? (size_t)HALF * BK * 2 : hstep, tstepB = g.b_tiled ? (size_t)(K / BK) * BM * BK * 2 : tstep;
    const unsigned ldsw = (unsigned)wid * 1024u;
    const int aoff = lds_byte(wr * 64 + fr, fq * 8), boff = lds_byte(wc * 32 + fr, fq * 8);
#define PG8_SA(b, h) (((b) * 2 + (h)) * HTB)
#define PG8_SB(b, h) ((4 + (b) * 2 + (h)) * HTB)
#define PG8_STAGE(bufoff, gbase, voff) do { _Pragma("unroll") for (int _i = 0; _i < 2; ++_i) \
        __builtin_amdgcn_global_load_lds((const unsigned*)((const char*)(gbase) + (voff)[_i]), (PG8_LAS unsigned*)(lds + (bufoff) + ldsw + _i * 8192), 16, 0, 0); } while (0)
#define PG8_LDA(dst, b, h) do { _Pragma("unroll") for (int m = 0; m < 4; ++m) _Pragma("unroll") for (int k = 0; k < 2; ++k) dst[m][k] = *(const PG8_LAS bf16x8*)(lds + PG8_SA(b, h) + aoff + m * 2048 + k * 1024); } while (0)
#define PG8_LDB(dst, b, h) do { _Pragma("unroll") for (int n = 0; n < 2; ++n) _Pragma("unroll") for (int k = 0; k < 2; ++k) dst[n][k] = *(const PG8_LAS bf16x8*)(lds + PG8_SB(b, h) + boff + n * 2048 + k * 1024); } while (0)
#define PG8_MMA(ai, bj, At, Bt) do { __builtin_amdgcn_s_setprio(1); _Pragma("unroll") for (int m = 0; m < 4; ++m) _Pragma("unroll") for (int n = 0; n < 2; ++n) _Pragma("unroll") for (int k = 0; k < 2; ++k) \
        acc[ai][bj][m][n] = __builtin_amdgcn_mfma_f32_16x16x32_bf16(Bt[n][k], At[m][k], acc[ai][bj][m][n], 0, 0, 0); __builtin_amdgcn_s_setprio(0); } while (0)
#define PG8_WAIT_V(n) asm volatile("s_waitcnt vmcnt(" #n ")" ::: "memory")
#define PG8_WAIT_L(n) asm volatile("s_waitcnt lgkmcnt(" #n ")" ::: "memory")
#define PG8_BAR __builtin_amdgcn_s_barrier()
#define PG8_SCHED __builtin_amdgcn_sched_barrier(0)
    Unit cur, nxt; int ui = 0;
    if (!S.next(0, cur)) return;
    f32x4 acc[2][2][4][2];
#pragma unroll
    for (int a = 0; a < 2; ++a)
#pragma unroll
        for (int b = 0; b < 2; ++b)
#pragma unroll
            for (int m = 0; m < 4; ++m)
#pragma unroll
                for (int n = 0; n < 2; ++n) acc[a][b][m][n] = (f32x4){0.f, 0.f, 0.f, 0.f};
    bf16x8 At[4][2], B0[2][2], B1[2][2];
    const char* cA = (const char*)g.A + (size_t)cur.pm * tstepA; const char* cB = (const char*)g.Bt + (size_t)cur.pn * tstepB;
    S.a_ready(cur);
    if constexpr (SP2) {
        PG8_STAGE(PG8_SB(0, 0), cB, voffB); PG8_STAGE(PG8_SB(0, 1), cB + hstepB, voffB); PG8_STAGE(PG8_SA(0, 0), cA, voffA); PG8_STAGE(PG8_SA(0, 1), cA + hstepA, voffA);
        if (wr == 1) PG8_BAR;
        PG8_WAIT_V(2); PG8_BAR;
        PG8_STAGE(PG8_SB(1, 0), cB + kstepB, voffB); PG8_STAGE(PG8_SA(1, 0), cA + kstepA, voffA); PG8_STAGE(PG8_SB(1, 1), cB + hstepB + kstepB, voffB);
        PG8_WAIT_V(6); PG8_BAR;
    } else {
        PG8_STAGE(PG8_SB(0, 0), cB, voffB); PG8_STAGE(PG8_SA(0, 0), cA, voffA); PG8_STAGE(PG8_SB(0, 1), cB + hstepB, voffB); PG8_STAGE(PG8_SA(0, 1), cA + hstepA, voffA);
        if (wr == 1) PG8_BAR;
        PG8_WAIT_V(4); PG8_BAR;
        PG8_STAGE(PG8_SB(1, 0), cB + kstepB, voffB); PG8_STAGE(PG8_SA(1, 0), cA + kstepA, voffA); PG8_STAGE(PG8_SB(1, 1), cB + hstepB + kstepB, voffB);
        PG8_WAIT_V(6); PG8_BAR;
    }
    for (;;) {
        const bool has_next = S.next(ui + 1, nxt);
        const char* nA = has_next ? (const char*)g.A + (size_t)nxt.pm * tstepA : cA; const char* nB = has_next ? (const char*)g.Bt + (size_t)nxt.pn * tstepB : cB;
        for (int t = 0; t < nt; t += 2) {
            const bool last = (t == nt - 2);
            const char* a1 = cA + (size_t)(t + 1) * kstepA;
            const char* a2 = last ? nA : cA + (size_t)(t + 2) * kstepA; const char* b2 = last ? nB : cB + (size_t)(t + 2) * kstepB;
            const char* a3 = a2 + kstepA; const char* b3 = b2 + kstepB;
            if (last && has_next) S.a_ready(nxt);
            if constexpr (SP2) {
            PG8_LDB(B0, 0, 0); PG8_LDB(B1, 0, 1); PG8_SCHED; PG8_LDA(At, 0, 0); PG8_STAGE(PG8_SA(1, 1), a1 + hstepA, voffA);
            PG8_WAIT_V(8); PG8_WAIT_L(0); PG8_BAR; PG8_MMA(0, 0, At, B0); PG8_MMA(0, 1, At, B1); PG8_BAR; PG8_SCHED;
            PG8_LDA(At, 0, 1); PG8_STAGE(PG8_SB(0, 0), b2, voffB); PG8_STAGE(PG8_SB(0, 1), b2 + hstepB, voffB); PG8_STAGE(PG8_SA(0, 0), a2, voffA);
            PG8_WAIT_V(8); PG8_WAIT_L(0); PG8_BAR; PG8_MMA(1, 0, At, B0); PG8_MMA(1, 1, At, B1); PG8_BAR; PG8_SCHED;
            PG8_LDB(B0, 1, 0); PG8_LDB(B1, 1, 1); PG8_SCHED; PG8_LDA(At, 1, 0); PG8_STAGE(PG8_SA(0, 1), a2 + hstepA, voffA);
            PG8_WAIT_V(8); PG8_WAIT_L(0); PG8_BAR; PG8_MMA(0, 0, At, B0); PG8_MMA(0, 1, At, B1); PG8_BAR; PG8_SCHED;
            PG8_LDA(At, 1, 1); PG8_STAGE(PG8_SB(1, 0), b3, voffB); PG8_STAGE(PG8_SB(1, 1), b3 + hstepB, voffB); PG8_STAGE(PG8_SA(1, 0), a3, voffA);
            PG8_WAIT_V(8); PG8_WAIT_L(0); PG8_BAR; PG8_MMA(1, 0, At, B0); PG8_MMA(1, 1, At, B1); PG8_BAR; PG8_SCHED;
            } else {
            PG8_LDB(B0, 0, 0); PG8_SCHED; PG8_LDA(At, 0, 0); PG8_STAGE(PG8_SA(1, 1), a1 + hstepA, voffA);
            PG8_WAIT_L(8); PG8_BAR; PG8_WAIT_L(0); PG8_MMA(0, 0, At, B0); PG8_BAR; PG8_SCHED;
            PG8_LDB(B1, 0, 1); PG8_STAGE(PG8_SB(0, 0), b2, voffB);
            PG8_BAR; PG8_WAIT_L(0); PG8_MMA(0, 1, At, B1); PG8_BAR;
            PG8_LDA(At, 0, 1); PG8_STAGE(PG8_SA(0, 0), a2, voffA);
            PG8_BAR; PG8_WAIT_L(0); PG8_MMA(1, 0, At, B0); PG8_BAR; PG8_SCHED;
            PG8_STAGE(PG8_SB(0, 1), b2 + hstepB, voffB);
            PG8_WAIT_V(6); PG8_BAR; PG8_MMA(1, 1, At, B1); PG8_BAR;
            PG8_LDB(B0, 1, 0); PG8_SCHED; PG8_LDA(At, 1, 0); PG8_STAGE(PG8_SA(0, 1), a2 + hstepA, voffA);
            PG8_WAIT_L(8); PG8_BAR; PG8_WAIT_L(0); PG8_MMA(0, 0, At, B0); PG8_BAR; PG8_SCHED;
            PG8_LDB(B1, 1, 1); PG8_STAGE(PG8_SB(1, 0), b3, voffB);
            PG8_BAR; PG8_WAIT_L(0); PG8_MMA(0, 1, At, B1); PG8_BAR;
            PG8_LDA(At, 1, 1); PG8_STAGE(PG8_SA(1, 0), a3, voffA);
            PG8_BAR; PG8_WAIT_L(0); PG8_MMA(1, 0, At, B0); PG8_BAR; PG8_SCHED;
            PG8_STAGE(PG8_SB(1, 1), b3 + hstepB, voffB);
            PG8_WAIT_V(6); PG8_BAR; PG8_MMA(1, 1, At, B1); PG8_BAR;
            }
        }
        if constexpr (ALIGN_EPI) { if (wr == 0) PG8_BAR; }
        if constexpr (!Epi::AFTER_DRAIN) { E(acc, cur, wr, wc, fr, fq); S.done(cur); }
        if (!has_next) break;
#pragma unroll
        for (int a = 0; a < 2; ++a)
#pragma unroll
            for (int b = 0; b < 2; ++b)
#pragma unroll
                for (int m = 0; m < 4; ++m)
#pragma unroll
                    for (int n = 0; n < 2; ++n) acc[a][b][m][n] = (f32x4){0.f, 0.f, 0.f, 0.f};
        cur = nxt; cA = nA; cB = nB; ++ui;
        if constexpr (ALIGN_EPI) { if (wr == 1) PG8_BAR; }
    }
    PG8_WAIT_V(0);
    if constexpr (!ALIGN_EPI) { if (wr == 0) PG8_BAR; }
    PG8_BAR;
    if constexpr (Epi::AFTER_DRAIN) { E.fused(acc, cur, wr, wc, fr, fq, lds, wid, lane); S.done(cur); }
#undef PG8_SA
#undef PG8_SB
#undef PG8_STAGE
#undef PG8_LDA
#undef PG8_LDB
#undef PG8_MMA
#undef PG8_WAIT_V
#undef PG8_WAIT_L
#undef PG8_BAR
#undef PG8_SCHED
}
}

constexpr int BATCH = 8, SEQ = 2048, DM = 1024, MROWS = BATCH * SEQ, DFF = 2816, NFF2 = 2 * DFF, NINP = 4608, NIN = 4376;
constexpr int NWAVES = 8, NTHR = 512;
constexpr int LDS_BYTES = 147456;
constexpr int N_PHASES = 26;
#ifndef EN
#define EN 511
#endif
#ifndef FUSE_NORM
#define FUSE_NORM 1
#endif
#ifndef PROBE_REP
#define PROBE_REP 0
#endif
#ifndef PROBE_SYNC
#define PROBE_SYNC 0
#endif
constexpr float QSCALE = 0.125f * 1.4426950408889634f;
#define LAS __attribute__((address_space(3)))
typedef unsigned short bf16_t;
typedef short bf16x8 __attribute__((ext_vector_type(8)));
typedef short s16x4 __attribute__((ext_vector_type(4)));
typedef float f32x4 __attribute__((ext_vector_type(4)));
typedef float f32x16 __attribute__((ext_vector_type(16)));
typedef unsigned u32x2 __attribute__((ext_vector_type(2)));
typedef unsigned u32x4 __attribute__((ext_vector_type(4)));
#define MFMA32(a, b, c) __builtin_amdgcn_mfma_f32_32x32x16_bf16((a), (b), (c), 0, 0, 0)

constexpr size_t MiB = 1u << 20;
constexpr size_t WS_MODP = 0;
constexpr size_t WS_BAR = 4 * MiB + 768 * 1024;
constexpr size_t WS_CNT = WS_BAR + 16384;
constexpr size_t WS_XT = WS_CNT + 24576;
constexpr size_t WS_ROPE = 5 * MiB;
constexpr size_t WS_PECP = 5 * MiB + 768 * 1024;
constexpr size_t WS_W1T = 6 * MiB;
constexpr size_t WS_KC = 8 * MiB;
constexpr size_t WS_VC = 8 * MiB + 512 * 1024;
constexpr size_t WS_WFI = 10 * MiB;
constexpr size_t WS_WFO = 54 * MiB;
constexpr size_t WS_WMIX = 76 * MiB;
constexpr size_t WS_WPA = 94 * MiB;
constexpr size_t WS_WPB = 96 * MiB;
constexpr size_t WS_WO = 98 * MiB;
constexpr size_t WS_XN = 102 * MiB;
constexpr size_t WS_YA = 102 * MiB, WS_YB = 118 * MiB;
constexpr size_t WS_HID = 134 * MiB;
constexpr size_t WS_QR = 134 * MiB;
constexpr size_t WS_KV = 150 * MiB;
constexpr size_t WS_EW = 176 * MiB;
constexpr size_t WS_GATES = 272 * MiB;
constexpr size_t WS_MG = 134 * MiB;
constexpr size_t WS_END = 274 * MiB;

struct Args { const float* in[19]; float* out; unsigned char* ws; int ph_lo, ph_hi; };
typedef const __attribute__((address_space(4))) Args* CArgsP;

__device__ __forceinline__ unsigned pk2(float lo, float hi) {
    typedef float f2 __attribute__((ext_vector_type(2))); typedef __bf16 b2 __attribute__((ext_vector_type(2)));
    f2 v = {lo, hi}; b2 b = __builtin_convertvector(v, b2); return __builtin_bit_cast(unsigned, b);
}
__device__ __forceinline__ float bf_lo(unsigned u) { return __uint_as_float(u << 16); }
__device__ __forceinline__ float bf_hi(unsigned u) { return __uint_as_float(u & 0xffff0000u); }
__device__ __forceinline__ float fexp2(float x) { return __builtin_amdgcn_exp2f(x); }
__device__ __forceinline__ float frcp(float x) { return __builtin_amdgcn_rcpf(x); }
__device__ __forceinline__ float sigm(float x) { return frcp(1.f + fexp2(-1.4426950408889634f * x)); }
__device__ __forceinline__ float silu_f(float x) { return x * sigm(x); }
__device__ __forceinline__ float gelu_tanh_f(float x) { return x * sigm(1.5957691216057308f * (x + 0.044715f * x * x * x)); }
__device__ __forceinline__ float wave_sum(float v) {
#pragma unroll
    for (int o = 1; o < 64; o <<= 1) v += __shfl_xor(v, o);
    return v;
}
__device__ __forceinline__ int crow(int r, int hi) { return (r & 3) + 8 * (r >> 2) + 4 * hi; }
__device__ __forceinline__ s16x4 tr_read(LAS unsigned char* p) { return __builtin_amdgcn_ds_read_tr16_b64_v4i16((LAS s16x4*)p); }
__device__ __forceinline__ bf16x8 cat8(s16x4 a, s16x4 b) { return __builtin_shufflevector(a, b, 0, 1, 2, 3, 4, 5, 6, 7); }
#define PACK8(S, sp) ({ u32x4 _p; _p.x = pk2((S)[8 * (sp) + 0], (S)[8 * (sp) + 1]); _p.y = pk2((S)[8 * (sp) + 2], (S)[8 * (sp) + 3]); \
                        _p.z = pk2((S)[8 * (sp) + 4], (S)[8 * (sp) + 5]); _p.w = pk2((S)[8 * (sp) + 6], (S)[8 * (sp) + 7]); __builtin_bit_cast(bf16x8, _p); })

__device__ __forceinline__ unsigned xb_xcc_id();
__device__ __forceinline__ f32x4 modv4(const float* modp, const float* adab, int l, int b, int idx) {
    f32x4 s = *(const f32x4*)(adab + l * 9216 + idx);
#pragma unroll
    for (int kc = 0; kc < 8; ++kc) s += *(const f32x4*)(modp + (size_t)((l * 8 + kc) * 8 + b) * 9216 + idx);
    return s;
}

__device__ __forceinline__ int rowmap(int mode, int n) {
    if (mode == 1) { return n < DFF ? ((n >> 7) * 256 + (n & 127)) : (((n - DFF) >> 7) * 256 + 128 + ((n - DFF) & 127)); }
    if (mode == 2) {
        if (n >= 1304) return n - 24;
        if (n >= 1280) return 4352 + (n - 1280);
        { const int d = n & 63; return (n & ~63) | (((d >> 4) & 1) << 5) | (((d >> 2) & 3) << 3) | ((d >> 5) << 2) | (d & 3); }
    }
    return n;
}
__device__ __forceinline__ void tr_item(const float* W, int K, int N, bf16_t* WT, int mode, LAS float* scr, int item, int lane, int tiled = 1) {
    const int nblk = (N + 31) / 32, kb = item / nblk, nb = item % nblk, k0 = 64 * kb, n0 = 32 * nb;
    const int nn = n0 + (lane & 31);
    float tv[32];
    const float* wp = W + (size_t)(k0 + (lane >> 5)) * N + (nn < N ? nn : 0);
#pragma unroll
    for (int i = 0; i < 32; ++i) tv[i] = wp[(size_t)(2 * i) * N];
#pragma unroll
    for (int i = 0; i < 32; ++i) scr[(2 * i + (lane >> 5)) * 33 + (lane & 31)] = (nn < N) ? tv[i] : 0.f;
    asm volatile("s_waitcnt lgkmcnt(0)" ::: "memory");
    const int c = lane & 7;
#pragma unroll
    for (int j = 0; j < 4; ++j) {
        const int n = (lane >> 3) + 8 * j; const LAS float* s = scr + (8 * c) * 33 + n;
        u32x4 o; o.x = pk2(s[0 * 33], s[1 * 33]); o.y = pk2(s[2 * 33], s[3 * 33]); o.z = pk2(s[4 * 33], s[5 * 33]); o.w = pk2(s[6 * 33], s[7 * 33]);
        if (n0 + n < N) {
            const int pr = rowmap(mode, n0 + n);
            const size_t off = tiled ? ((size_t)((pr >> 8) * (K >> 6) + (k0 >> 6)) * 256 + (pr & 255)) * 64 + 8 * c : (size_t)pr * K + k0 + 8 * c;
            *(u32x4*)(WT + off) = o;
        }
    }
    asm volatile("s_waitcnt lgkmcnt(0)" ::: "memory");
}

constexpr int I_FI = 16 * 176, I_FO = 44 * 32, I_MIX = 16 * 137, I_P = 8 * 32, I_O = 16 * 32, I_W1 = 32 * 4;
constexpr int LAYER_ITEMS = 1152 + 2 * I_FI + 2 * I_FO + I_MIX + 2 * I_P + I_O + 2 * I_W1 + 64;
#ifndef BG_PREP
#define BG_PREP 1
#endif
__device__ __forceinline__ void prep_sc(CArgsP a, LAS unsigned char* lds, int tid) {
    LAS float* SC = (LAS float*)lds; const float* c = a->in[1];
    __syncthreads();
    for (int i = tid; i < 8192; i += NTHR) { const float v = c[i]; SC[i] = silu_f(v); }
    __syncthreads();
}
__device__ __forceinline__ void prep_items(CArgsP a, LAS unsigned char* lds, int l, int lo, int hi, int first, int stride, int wave, int lane) {
    LAS float* SC = (LAS float*)lds;
    LAS float* scr = (LAS float*)(lds + 32768 + wave * 8448);
    bf16_t* WFI = (bf16_t*)(a->ws + WS_WFI); bf16_t* WFO = (bf16_t*)(a->ws + WS_WFO); bf16_t* WMIX = (bf16_t*)(a->ws + WS_WMIX);
    bf16_t* WPA = (bf16_t*)(a->ws + WS_WPA); bf16_t* WPB = (bf16_t*)(a->ws + WS_WPB); bf16_t* WO = (bf16_t*)(a->ws + WS_WO); bf16_t* W1T = (bf16_t*)(a->ws + WS_W1T);
    for (int it = lo + first; it < hi; it += stride) {
        int r = it;
        if (r < 1152) {
            const float* ada_w = a->in[2]; float* modp = (float*)(a->ws + WS_MODP);
            const int cb = r >> 3, kc = r & 7, col = cb * 64 + lane;
            const float* W = ada_w + (size_t)l * 1024 * 9216 + col;
            float acc[8];
#pragma unroll
            for (int b = 0; b < 8; ++b) acc[b] = 0.f;
            for (int k16 = 0; k16 < 8; ++k16) {
                const int kb = kc * 128 + k16 * 16;
                float wv[16];
#pragma unroll
                for (int i = 0; i < 16; ++i) wv[i] = W[(size_t)(kb + i) * 9216];
#pragma unroll
                for (int i4 = 0; i4 < 4; ++i4)
#pragma unroll
                    for (int b = 0; b < 8; ++b) { const f32x4 sv = *(const LAS f32x4*)(SC + b * 1024 + kb + 4 * i4); acc[b] += sv.x * wv[4 * i4] + sv.y * wv[4 * i4 + 1] + sv.z * wv[4 * i4 + 2] + sv.w * wv[4 * i4 + 3]; }
            }
#pragma unroll
            for (int b = 0; b < 8; ++b) modp[(size_t)((l * 8 + kc) * 8 + b) * 9216 + col] = acc[b];
            continue;
        }
        r -= 1152;
        if (r < 2 * I_FI) { const int w = l * 2 + r / I_FI; tr_item(a->in[5] + (size_t)w * 1024 * NFF2, 1024, NFF2, WFI + (size_t)w * NFF2 * 1024, 1, scr, r % I_FI, lane); continue; } r -= 2 * I_FI;
        if (r < 2 * I_FO) { const int w = l * 2 + r / I_FO; tr_item(a->in[6] + (size_t)w * DFF * 1024, DFF, 1024, WFO + (size_t)w * 1024 * DFF, 0, scr, r % I_FO, lane); continue; } r -= 2 * I_FO;
        if (r < I_MIX) { tr_item(a->in[7] + (size_t)l * 1024 * NIN, 1024, NIN, WMIX + (size_t)l * NINP * 1024, 2, scr, r, lane); continue; } r -= I_MIX;
        if (r < I_P) { tr_item(a->in[15] + (size_t)l * 512 * 1024, 512, 1024, WPA + (size_t)l * 1024 * 512, 0, scr, r, lane); continue; } r -= I_P;
        if (r < I_P) { tr_item(a->in[16] + (size_t)l * 512 * 1024, 512, 1024, WPB + (size_t)l * 1024 * 512, 0, scr, r, lane); continue; } r -= I_P;
        if (r < I_O) { tr_item(a->in[17] + (size_t)l * 1024 * 1024, 1024, 1024, WO + (size_t)l * 1024 * 1024, 0, scr, r, lane); continue; } r -= I_O;
        if (r < 2 * I_W1) { const int w = l * 2 + r / I_W1; tr_item(a->in[9] + (size_t)w * 2048 * 128, 2048, 128, W1T + (size_t)w * 128 * 2048, 0, scr, r % I_W1, lane, 0); continue; } r -= 2 * I_W1;
        {
            const float* pe = a->in[8]; const float* w1 = a->in[9]; float* pecp = (float*)(a->ws + WS_PECP);
            const int lj = l * 2 + (r >> 5), fc = (r >> 4) & 1, kc = r & 15, f = fc * 64 + lane;
            float acc = 0.f;
#pragma unroll 8
            for (int k = kc * 128; k < kc * 128 + 128; ++k) acc += pe[lj * 2048 + k] * w1[((size_t)lj * 2048 + k) * 128 + f];
            pecp[(lj * 16 + kc) * 128 + f] = acc;
        }
    }
}
__device__ __forceinline__ void bg_prep(CArgsP a, LAS unsigned char* lds, int nwg, int half, int G, int bid, int tid, int wave, int lane) {
    const int rem = nwg % G, first_idle = rem, nidle = G - rem;
    if (bid < first_idle) return;
    prep_sc(a, lds, tid);
    const int lo = (LAYER_ITEMS * half) / 3, hi = (LAYER_ITEMS * (half + 1)) / 3;
    prep_items(a, lds, 1, lo, hi, (bid - first_idle) * NWAVES + wave, nidle * NWAVES, wave, lane);
}

__device__ __forceinline__ void phase_prologue(CArgsP a, LAS unsigned char* lds, int tid, int wave, int lane) {
    const int G = gridDim.x, gw = blockIdx.x * NWAVES + wave, NGW = G * NWAVES;
    if (tid == 0) {
        pg8::StaticOrder S; S.init(MROWS, 1024, G, (int)blockIdx.x); pg8::Unit u;
        if (S.next(0, u)) ((unsigned*)(a->ws + WS_XT))[u.pm * 4 + u.pn] = xb_xcc_id() + 1u;
    }
    prep_sc(a, lds, tid);
    prep_items(a, lds, 0, 0, LAYER_ITEMS, gw, NGW, wave, lane);
    if (!BG_PREP) prep_items(a, lds, 1, 0, LAYER_ITEMS, gw, NGW, wave, lane);
    {
        float* rc = (float*)(a->ws + WS_ROPE); float* rs = rc + 65536;
        for (int i = blockIdx.x * NTHR + tid; i < 65536; i += G * NTHR) {
            const int pos = i >> 5, f = i & 31;
            const float inv = exp2f(-(float)f * (13.287712379549449f / 32.f));
            const float angf = (float)pos * inv;
            double t = (double)angf * 0.15915494309189535; t -= floor(t);
            const float tf = (float)t;
            rc[i] = __builtin_amdgcn_cosf(tf); rs[i] = __builtin_amdgcn_sinf(tf);
        }
    }
}

__device__ __forceinline__ void phase_norm(CArgsP a, LAS unsigned char* lds, const float* hin, int l, int sub, int tid, int wave, int lane) {
    LAS float* SH = (LAS float*)lds;
    const float* modp = (const float*)(a->ws + WS_MODP); const float* adab = a->in[3];
    const float* gvec = a->in[4] + (l * 3 + sub) * 1024;
    bf16_t* XN = (bf16_t*)(a->ws + WS_XN);
    for (int blk = blockIdx.x; blk < 256; blk += gridDim.x) {
        const int b = blk >> 5;
        __syncthreads();
        { const int which = tid >> 8, c4 = 4 * (tid & 255);
          f32x4 v = modv4(modp, adab, l, b, (sub * 3 + which) * 1024 + c4);
          if (which) v += 1.f;
          *(LAS f32x4*)(SH + which * 1024 + c4) = v; }
        __syncthreads();
        for (int rr = 0; rr < 8; ++rr) {
            const int row = blk * 64 + wave * 8 + rr;
            const f32x4* xr = (const f32x4*)(hin + (size_t)row * 1024) + lane;
            f32x4 v[4]; float ss = 0.f;
#pragma unroll
            for (int j = 0; j < 4; ++j) { v[j] = xr[64 * j]; ss += (v[j].x * v[j].x + v[j].y * v[j].y) + (v[j].z * v[j].z + v[j].w * v[j].w); }
            const float rstd = rsqrtf(wave_sum(ss) * (1.f / 1024.f) + 1e-6f);
#pragma unroll
            for (int j = 0; j < 4; ++j) {
                const int col = 4 * lane + 256 * j;
                const f32x4 g4 = *(const f32x4*)(gvec + col), sh = *(const LAS f32x4*)(SH + col), sc = *(const LAS f32x4*)(SH + 1024 + col);
                const f32x4 o = (v[j] * rstd) * g4 * sc + sh;
                u32x2 w; w.x = pk2(o.x, o.y); w.y = pk2(o.z, o.w);
                *(u32x2*)(XN + (size_t)row * 1024 + col) = w;
            }
        }
    }
}
__device__ __forceinline__ void phase_final_norm(CArgsP a, int wave, int lane) {
    const float* gvec = a->in[18];
    const int gw = blockIdx.x * NWAVES + wave, NGW = gridDim.x * NWAVES;
    for (int row = gw; row < MROWS; row += NGW) {
        f32x4* xr = (f32x4*)(a->out + (size_t)row * 1024) + lane;
        f32x4 v[4]; float ss = 0.f;
#pragma unroll
        for (int j = 0; j < 4; ++j) { v[j] = xr[64 * j]; ss += (v[j].x * v[j].x + v[j].y * v[j].y) + (v[j].z * v[j].z + v[j].w * v[j].w); }
        const float rstd = rsqrtf(wave_sum(ss) * (1.f / 1024.f) + 1e-6f);
#pragma unroll
        for (int j = 0; j < 4; ++j) { const f32x4 g4 = *(const f32x4*)(gvec + 4 * lane + 256 * j); xr[64 * j] = (v[j] * rstd) * g4; }
    }
}

struct EpiSwiglu {
    static constexpr bool PERM = true, AFTER_DRAIN = false;
    bf16_t* HID;
    __device__ __forceinline__ void operator()(const pg8::f32x4 (&acc)[2][2][4][2], const pg8::Unit& u, int wr, int wc, int fr, int fq) const {
        const int R0 = wr * 64 + fr, hc = u.pn * 128 + wc * 32 + 8 * fq;
        bf16_t* tp = HID + ((size_t)(u.pm * (DFF / 64) + (hc >> 6)) * 256) * 64 + (hc & 63);
#pragma unroll
        for (int ai = 0; ai < 2; ++ai)
#pragma unroll
            for (int m = 0; m < 4; ++m) {
                const pg8::f32x4 x0 = acc[ai][0][m][0], y0 = acc[ai][1][m][0], x1 = acc[ai][0][m][1], y1 = acc[ai][1][m][1];
                u32x4 w;
                w.x = pk2(silu_f(x0[0]) * y0[0], silu_f(x0[1]) * y0[1]); w.y = pk2(silu_f(x0[2]) * y0[2], silu_f(x0[3]) * y0[3]);
                w.z = pk2(silu_f(x1[0]) * y1[0], silu_f(x1[1]) * y1[1]); w.w = pk2(silu_f(x1[2]) * y1[2], silu_f(x1[3]) * y1[3]);
                *(u32x4*)(tp + (size_t)(R0 + ai * 128 + m * 16) * 64) = w;
            }
    }
};
struct EpiResid {
    static constexpr bool PERM = false, AFTER_DRAIN = false;
    const float* hin; float* hout; const float* modp; const float* adab; int l, gidx; float scl;
    __device__ __forceinline__ void operator()(const pg8::f32x4 (&acc)[2][2][4][2], const pg8::Unit& u, int wr, int wc, int fr, int fq) const {
        const int row0 = u.pm * 256 + wr * 64 + fr, b = u.pm >> 3, colb = u.pn * 256 + wc * 32 + 4 * fq;
        f32x4 g4[2][2];
#pragma unroll
        for (int bj = 0; bj < 2; ++bj)
#pragma unroll
            for (int n = 0; n < 2; ++n) g4[bj][n] = modv4(modp, adab, l, b, gidx + colb + bj * 128 + n * 16) * scl;
#pragma unroll
        for (int ai = 0; ai < 2; ++ai)
#pragma unroll
            for (int mh = 0; mh < 2; ++mh) {
                f32x4 hv[2][2][2];
#pragma unroll
                for (int m2 = 0; m2 < 2; ++m2)
#pragma unroll
                    for (int bj = 0; bj < 2; ++bj)
#pragma unroll
                        for (int n = 0; n < 2; ++n) hv[m2][bj][n] = *(const f32x4*)(hin + (size_t)(row0 + ai * 128 + (mh * 2 + m2) * 16) * 1024 + colb + bj * 128 + n * 16);
#pragma unroll
                for (int m2 = 0; m2 < 2; ++m2)
#pragma unroll
                    for (int bj = 0; bj < 2; ++bj)
#pragma unroll
                        for (int n = 0; n < 2; ++n) *(f32x4*)(hout + (size_t)(row0 + ai * 128 + (mh * 2 + m2) * 16) * 1024 + colb + bj * 128 + n * 16) = hv[m2][bj][n] + g4[bj][n] * acc[ai][bj][mh * 2 + m2][n];
            }
    }
};
struct EpiMix {
    static constexpr bool PERM = true, AFTER_DRAIN = false;
    bf16_t *QR, *KV, *EW; float* GATES; const float *rc, *rs;
    __device__ __forceinline__ void operator()(const pg8::f32x4 (&acc)[2][2][4][2], const pg8::Unit& u, int wr, int wc, int fr, int fq) const {
        const int row0 = u.pm * 256 + wr * 64 + fr;
        if (u.pn < 5) {
#pragma unroll
            for (int bj = 0; bj < 2; ++bj) {
                const int blk64 = u.pn * 4 + bj * 2 + (wc >> 1);
                const bool isq = blk64 < 8; const int kvb = blk64 - 8, jkv = kvb >> 1;
                const bool rope = isq || jkv == 2 || jkv == 4;
                const float scl = isq ? QSCALE : 1.f;
                bf16_t* dst = isq ? (QR + blk64 * 64) : (KV + kvb * 64); const int ld = isq ? 512 : 768;
                const int d0 = 16 * (wc & 1) + 4 * fq;
#pragma unroll
                for (int ai = 0; ai < 2; ++ai) {
                    f32x4 csv[4], snv[4];
                    if (rope) {
#pragma unroll
                        for (int m = 0; m < 4; ++m) { const int pos = (row0 + ai * 128 + m * 16) & 2047; csv[m] = *(const f32x4*)(rc + pos * 32 + d0); snv[m] = *(const f32x4*)(rs + pos * 32 + d0); }
                    }
#pragma unroll
                    for (int m = 0; m < 4; ++m) {
                        const int row = row0 + ai * 128 + m * 16;
                        f32x4 v0 = acc[ai][bj][m][0], v1 = acc[ai][bj][m][1];
                        if (rope) {
                            const f32x4 cs = csv[m], sn = snv[m];
                            const f32x4 o0 = v0 * cs - v1 * sn, o1 = v1 * cs + v0 * sn; v0 = o0; v1 = o1;
                        }
                        v0 *= scl; v1 *= scl;
                        u32x2 w0, w1; w0.x = pk2(v0.x, v0.y); w0.y = pk2(v0.z, v0.w); w1.x = pk2(v1.x, v1.y); w1.y = pk2(v1.z, v1.w);
                        bf16_t* rp = dst + (size_t)row * ld + d0;
                        *(u32x2*)rp = w0; *(u32x2*)(rp + 32) = w1;
                    }
                }
            }
        } else if (u.pn < 17) {
            const bool isgelu = u.pn < 9;
#pragma unroll
            for (int bj = 0; bj < 2; ++bj) {
                const int col = (u.pn - 5) * 256 + bj * 128 + wc * 32 + 8 * fq;
#pragma unroll
                for (int ai = 0; ai < 2; ++ai)
#pragma unroll
                    for (int m = 0; m < 4; ++m) {
                        const int row = row0 + ai * 128 + m * 16;
                        u32x4 w;
#pragma unroll
                        for (int n = 0; n < 2; ++n) {
                            const f32x4 v = acc[ai][bj][m][n]; f32x4 o;
                            if (isgelu) { o.x = gelu_tanh_f(v.x); o.y = gelu_tanh_f(v.y); o.z = gelu_tanh_f(v.z); o.w = gelu_tanh_f(v.w); }
                            else { o.x = sigm(v.x); o.y = sigm(v.y); o.z = sigm(v.z); o.w = sigm(v.w); }
                            if (n == 0) { w.x = pk2(o.x, o.y); w.y = pk2(o.z, o.w); } else { w.z = pk2(o.x, o.y); w.w = pk2(o.z, o.w); }
                        }
                        *(u32x4*)(EW + (size_t)row * 3072 + col) = w;
                    }
            }
        } else {
            if (wc == 0) {
#pragma unroll
                for (int n = 0; n < 2; ++n) {
                    const int c = 8 * fq + 4 * n;
                    if (c < 24) {
#pragma unroll
                        for (int ai = 0; ai < 2; ++ai)
#pragma unroll
                            for (int m = 0; m < 4; ++m) {
                                const int row = row0 + ai * 128 + m * 16;
                                const f32x4 v = acc[ai][0][m][n]; f32x4 o; o.x = sigm(v.x); o.y = sigm(v.y); o.z = sigm(v.z); o.w = sigm(v.w);
                                *(f32x4*)(GATES + (size_t)row * 24 + c) = o;
                            }
                    }
                }
            }
        }
    }
};
template <int SECOND> struct EpiProj {
    static constexpr bool PERM = true, AFTER_DRAIN = false;
    const bf16_t* EW; bf16_t* MG;
    __device__ __forceinline__ void operator()(const pg8::f32x4 (&acc)[2][2][4][2], const pg8::Unit& u, int wr, int wc, int fr, int fq) const {
        const int row0 = u.pm * 256 + wr * 64 + fr, colb = u.pn * 256 + wc * 32 + 8 * fq;
#pragma unroll
        for (int ai = 0; ai < 2; ++ai)
#pragma unroll
            for (int mh = 0; mh < 2; ++mh) {
                u32x4 gw[2][2]; unsigned long long pv[2][2][2];
#pragma unroll
                for (int m2 = 0; m2 < 2; ++m2)
#pragma unroll
                    for (int bj = 0; bj < 2; ++bj) {
                        const int row = row0 + ai * 128 + (mh * 2 + m2) * 16, col = colb + bj * 128;
                        gw[m2][bj] = *(const u32x4*)(EW + (size_t)row * 3072 + (SECOND ? 2048 : 1024) + col);
                        if (SECOND) {
                            unsigned long long* mp = (unsigned long long*)(MG + (size_t)row * 1024 + col);
                            pv[m2][bj][0] = __hip_atomic_load(mp, __ATOMIC_RELAXED, __HIP_MEMORY_SCOPE_AGENT);
                            pv[m2][bj][1] = __hip_atomic_load(mp + 1, __ATOMIC_RELAXED, __HIP_MEMORY_SCOPE_AGENT);
                        }
                    }
#pragma unroll
                for (int m2 = 0; m2 < 2; ++m2)
#pragma unroll
                    for (int bj = 0; bj < 2; ++bj) {
                        const int row = row0 + ai * 128 + (mh * 2 + m2) * 16, col = colb + bj * 128;
                        const u32x4 g = gw[m2][bj]; u32x4 w;
#pragma unroll
                        for (int n = 0; n < 2; ++n) {
                            const f32x4 v = acc[ai][bj][mh * 2 + m2][n];
                            const unsigned g0 = n ? g.z : g.x, g1 = n ? g.w : g.y;
                            float o0 = bf_lo(g0) * v.x, o1 = bf_hi(g0) * v.y, o2 = bf_lo(g1) * v.z, o3 = bf_hi(g1) * v.w;
                            if (SECOND) { const unsigned plo = (unsigned)pv[m2][bj][n], phi = (unsigned)(pv[m2][bj][n] >> 32); o0 += bf_lo(plo); o1 += bf_hi(plo); o2 += bf_lo(phi); o3 += bf_hi(phi); }
                            if (n == 0) { w.x = pk2(o0, o1); w.y = pk2(o2, o3); } else { w.z = pk2(o0, o1); w.w = pk2(o2, o3); }
                        }
                        *(u32x4*)(MG + (size_t)row * 1024 + col) = w;
                    }
            }
    }
};

__device__ __forceinline__ void compress_unit(CArgsP a, LAS unsigned char* lds, int l, int u, int tid, int wave, int lane) {
    const int b = u >> 5, g = (u >> 4) & 1, j = (u >> 3) & 1, nb = u & 7;
    LAS float* H = (LAS float*)lds;
    LAS float* OB = H + 16 * 129;
    LAS float* W2s = OB + 16 * 65;
    const bf16_t* KV = (const bf16_t*)(a->ws + WS_KV); const bf16_t* W1T = (const bf16_t*)(a->ws + WS_W1T);
    const float* pecp = (const float*)(a->ws + WS_PECP); const float* w2 = a->in[10] + (size_t)(l * 2 + j) * 128 * 64;
    const float* rc = (const float*)(a->ws + WS_ROPE); const float* rs = rc + 65536;
    const int fr = lane & 15, fq = lane >> 4;
    {
        f32x4 wt[4];
#pragma unroll
        for (int i = 0; i < 4; ++i) wt[i] = *(const f32x4*)(w2 + (i * 512 + tid) * 4);
#pragma unroll
        for (int i = 0; i < 4; ++i) *(LAS f32x4*)(W2s + (i * 512 + tid) * 4) = wt[i];
    }
    {
        const int n = nb * 16 + fr;
        const bf16_t* Ab = KV + (size_t)(b * 2048 + 16 * n) * 768 + (j * 2 + g) * 64;
        const bf16_t* Bb = W1T + (size_t)((l * 2 + j) * 128 + wave * 16 + fr) * 2048;
        f32x4 acc = {0.f, 0.f, 0.f, 0.f};
        bf16x8 a0[4], b0[4], a1[4], b1[4];
#define CMP_LOAD(A_, B_, it_) _Pragma("unroll") for (int i_ = 0; i_ < 4; ++i_) { const int k_ = ((it_) * 4 + i_) * 32 + 8 * fq; A_[i_] = *(const bf16x8*)(Ab + (k_ >> 6) * 768 + (k_ & 63)); B_[i_] = *(const bf16x8*)(Bb + k_); }
#define CMP_MMA(A_, B_) _Pragma("unroll") for (int i_ = 0; i_ < 4; ++i_) acc = __builtin_amdgcn_mfma_f32_16x16x32_bf16(A_[i_], B_[i_], acc, 0, 0, 0);
        CMP_LOAD(a0, b0, 0)
#pragma unroll 1
        for (int it = 0; it < 16; it += 2) {
            CMP_LOAD(a1, b1, it + 1)
            CMP_MMA(a0, b0)
            if (it + 2 < 16) { CMP_LOAD(a0, b0, it + 2) }
            CMP_MMA(a1, b1)
        }
#undef CMP_LOAD
#undef CMP_MMA
#pragma unroll
        for (int r = 0; r < 4; ++r) H[(4 * fq + r) * 129 + wave * 16 + fr] = acc[r];
    }
    __syncthreads();
    {
        const int f = tid & 127; float pec = 0.f;
#pragma unroll
        for (int kc = 0; kc < 16; ++kc) pec += pecp[((l * 2 + j) * 16 + kc) * 128 + f];
#pragma unroll
        for (int i = 0; i < 4; ++i) { const int n = (tid >> 7) + 4 * i; H[n * 129 + f] = silu_f(H[n * 129 + f] + pec); }
    }
    __syncthreads();
    const int n = tid >> 5, d2 = (tid & 31) * 2;
    float o0 = 0.f, o1 = 0.f;
#pragma unroll 8
    for (int f = 0; f < 128; ++f) { const float hv = H[n * 129 + f]; const float w0 = W2s[f * 64 + d2], w1 = W2s[f * 64 + d2 + 1]; o0 += hv * w0; o1 += hv * w1; }
    const int ng = nb * 16 + n;
    if (j == 0) {
        OB[n * 65 + d2] = o0; OB[n * 65 + d2 + 1] = o1;
        __syncthreads();
        const int pos = 16 * ng + 31, dd = d2 & 31;
        const float c0 = rc[pos * 32 + dd], c1 = rc[pos * 32 + dd + 1], s0 = rs[pos * 32 + dd], s1 = rs[pos * 32 + dd + 1];
        const int od = d2 < 32 ? d2 + 32 : d2 - 32;
        const float p0 = OB[n * 65 + od], p1 = OB[n * 65 + od + 1];
        if (d2 < 32) { o0 = o0 * c0 - p0 * s0; o1 = o1 * c1 - p1 * s1; } else { o0 = o0 * c0 + p0 * s0; o1 = o1 * c1 + p1 * s1; }
    }
    if (ng == 127) { o0 = 0.f; o1 = 0.f; }
    bf16_t* dst = (bf16_t*)(a->ws + (j ? WS_VC : WS_KC)) + (size_t)((b * 2 + g) * 128 + ng) * 64 + d2;
    *(unsigned*)dst = pk2(o0, o1);
    __syncthreads();
}

__device__ __forceinline__ void gmlp_unit(CArgsP a, LAS unsigned char* lds, int l, int u, int tid, int wave, int lane) {
    const int b = u >> 5, ch = (u >> 1) & 15, h2 = u & 1;
    const int R0 = b * 2048 + ch * 128;
    const bf16_t* EW = (const bf16_t*)(a->ws + WS_EW); bf16_t* YB = (bf16_t*)(a->ws + WS_YB);
    const float* lng = a->in[11] + l * 512; const float* lnb = a->in[12] + l * 512;
    const float* gws = a->in[13] + (size_t)l * 8 * 128 * 128; const float* gbs = a->in[14] + l * 8 * 128;
    LAS unsigned char* VN = lds;
    {
        const f32x4 g0 = *(const f32x4*)(lng + 8 * lane), g1 = *(const f32x4*)(lng + 8 * lane + 4);
        const f32x4 b0 = *(const f32x4*)(lnb + 8 * lane), b1 = *(const f32x4*)(lnb + 8 * lane + 4);
#pragma unroll 1
        for (int rb = 0; rb < 2; ++rb) {
        u32x4 raw[8];
#pragma unroll
        for (int rr = 0; rr < 8; ++rr) raw[rr] = *(const u32x4*)(EW + (size_t)(R0 + wave * 16 + rb * 8 + rr) * 3072 + 512 + 8 * lane);
#pragma unroll
        for (int rr = 0; rr < 8; ++rr) {
            const int srow = wave * 16 + rb * 8 + rr;
            float x[8] = {bf_lo(raw[rr].x), bf_hi(raw[rr].x), bf_lo(raw[rr].y), bf_hi(raw[rr].y), bf_lo(raw[rr].z), bf_hi(raw[rr].z), bf_lo(raw[rr].w), bf_hi(raw[rr].w)};
            float s = 0.f;
#pragma unroll
            for (int i = 0; i < 8; ++i) s += x[i];
            const float mu = wave_sum(s) * (1.f / 512.f);
            float qv = 0.f;
#pragma unroll
            for (int i = 0; i < 8; ++i) { x[i] -= mu; qv += x[i] * x[i]; }
            const float rstd = rsqrtf(wave_sum(qv) * (1.f / 512.f) + 1e-6f);
            u32x4 o;
            o.x = pk2(x[0] * rstd * g0.x + b0.x, x[1] * rstd * g0.y + b0.y); o.y = pk2(x[2] * rstd * g0.z + b0.z, x[3] * rstd * g0.w + b0.w);
            o.z = pk2(x[4] * rstd * g1.x + b1.x, x[5] * rstd * g1.y + b1.y); o.w = pk2(x[6] * rstd * g1.z + b1.z, x[7] * rstd * g1.w + b1.w);
            if ((lane >> 5) == h2) *(LAS u32x4*)(VN + srow * 576 + (lane & 31) * 16) = o;
        }
        }
    }
    __syncthreads();
    const int tb = wave >> 1, cb = wave & 1, q = lane & 31, hi = lane >> 5, blk = (lane >> 4) & 1, qq = (lane & 15) >> 2, p = lane & 3;
    const int t = 32 * tb + q, kmax = 2 * tb + 1;
    for (int gl = 0; gl < 4; ++gl) {
        const int g = h2 * 4 + gl;
        const float* wrow = gws + ((size_t)g * 128 + t) * 128;
        const int c = 64 * g + 32 * cb + q;
        f32x4 wa[8], wb[8];
#pragma unroll
        for (int ks = 0; ks < 8; ++ks) if (ks <= kmax) { wa[ks] = *(const f32x4*)(wrow + 16 * ks + 8 * hi); wb[ks] = *(const f32x4*)(wrow + 16 * ks + 8 * hi + 4); }
        unsigned short ur[16]; float br[16];
#pragma unroll
        for (int r = 0; r < 16; ++r) { const int tt = 32 * tb + crow(r, hi); ur[r] = EW[(size_t)(R0 + tt) * 3072 + c]; br[r] = gbs[g * 128 + tt]; }
        f32x16 acc;
#pragma unroll
        for (int i = 0; i < 16; ++i) acc[i] = 0.f;
#pragma unroll
        for (int ks = 0; ks < 8; ++ks) if (ks <= kmax) {
            const int s0 = 16 * ks + 8 * hi;
            const f32x4 w0 = wa[ks], w1 = wb[ks];
            u32x4 ap;
            ap.x = pk2(s0 + 0 <= t ? w0.x : 0.f, s0 + 1 <= t ? w0.y : 0.f); ap.y = pk2(s0 + 2 <= t ? w0.z : 0.f, s0 + 3 <= t ? w0.w : 0.f);
            ap.z = pk2(s0 + 4 <= t ? w1.x : 0.f, s0 + 5 <= t ? w1.y : 0.f); ap.w = pk2(s0 + 6 <= t ? w1.z : 0.f, s0 + 7 <= t ? w1.w : 0.f);
            LAS unsigned char* vp = VN + (16 * ks + 8 * hi + qq) * 576 + (64 * gl + 32 * cb + 16 * blk + 4 * p) * 2;
            const s16x4 lo = tr_read(vp), hi4 = tr_read(vp + 4 * 576);
            acc = MFMA32(__builtin_bit_cast(bf16x8, ap), cat8(lo, hi4), acc);
        }
#pragma unroll
        for (int r = 0; r < 16; ++r) {
            const int tt = 32 * tb + crow(r, hi); const size_t row = (size_t)(R0 + tt);
            const float y = __uint_as_float((unsigned)ur[r] << 16) * (acc[r] + br[r]);
            YB[row * 512 + c] = (bf16_t)(pk2(y, 0.f) & 0xffffu);
        }
    }
    __syncthreads();
}

constexpr int AT_BUF2 = 107520;
constexpr int AT_KT = 0, AT_VT = 9216, AT_KC = 21504, AT_VC = 39936, AT_IMP4 = 64512, AT_IMPF = AT_IMP4 + 33792, AT_SELM = AT_IMPF + 8448;

template <int MODE>
__device__ __forceinline__ void attn_tile(LAS unsigned char* KT, LAS unsigned char* VT, const bf16x8 (&qf)[4], float& m, float& lsum, f32x16 (&O)[2], int lane, int srel, bool mine, bool needmask) {
    const int q = lane & 31, hi = lane >> 5, blk = (lane >> 4) & 1, qq = (lane & 15) >> 2, p = lane & 3;
    f32x16 S0, S1;
#pragma unroll
    for (int i = 0; i < 16; ++i) { S0[i] = 0.f; S1[i] = 0.f; }
#pragma unroll
    for (int c = 0; c < 4; ++c) {
        const bf16x8 k0 = *(const LAS bf16x8*)(KT + q * 144 + (16 * c + 8 * hi) * 2);
        const bf16x8 k1 = *(const LAS bf16x8*)(KT + (32 + q) * 144 + (16 * c + 8 * hi) * 2);
        S0 = MFMA32(k0, qf[c], S0); S1 = MFMA32(k1, qf[c], S1);
    }
    if (needmask) {
#pragma unroll
        for (int r = 0; r < 16; ++r) {
            const int kk = crow(r, hi);
            bool v0, v1;
            if (MODE == 1) { v0 = mine && (kk <= srel); v1 = mine && (kk + 32 <= srel); }
            else { v0 = (kk <= srel) && (kk > srel - 512); v1 = (kk + 32 <= srel) && (kk + 32 > srel - 512); }
            S0[r] = v0 ? S0[r] : -1e30f; S1[r] = v1 ? S1[r] : -1e30f;
        }
    }
    float mx = fmaxf(S0[0], S1[0]);
#pragma unroll
    for (int r = 1; r < 16; ++r) mx = fmaxf(mx, fmaxf(S0[r], S1[r]));
    mx = fmaxf(mx, __shfl_xor(mx, 32));
    if (__ballot(mx > m + 6.f) != 0ull) {
        const float mnew = fmaxf(m, mx), alpha = fexp2(m - mnew);
        m = mnew; lsum *= alpha;
#pragma unroll
        for (int i = 0; i < 16; ++i) { O[0][i] *= alpha; O[1][i] *= alpha; }
    }
    float rs = 0.f;
#pragma unroll
    for (int r = 0; r < 16; ++r) { S0[r] = fexp2(S0[r] - m); S1[r] = fexp2(S1[r] - m); rs += S0[r] + S1[r]; }
    rs += __shfl_xor(rs, 32);
    lsum += rs;
#pragma unroll
    for (int sp = 0; sp < 2; ++sp) {
        const bf16x8 p0 = PACK8(S0, sp), p1 = PACK8(S1, sp);
#pragma unroll
        for (int dh = 0; dh < 2; ++dh) {
            LAS unsigned char* vp0 = VT + (16 * sp + 4 * hi + qq) * 192 + (32 * dh + 16 * blk + 4 * p) * 2;
            const bf16x8 vf0 = cat8(tr_read(vp0), tr_read(vp0 + 8 * 192));
            O[dh] = MFMA32(vf0, p0, O[dh]);
            LAS unsigned char* vp1 = vp0 + 32 * 192;
            const bf16x8 vf1 = cat8(tr_read(vp1), tr_read(vp1 + 8 * 192));
            O[dh] = MFMA32(vf1, p1, O[dh]);
        }
    }
}

__device__ __forceinline__ void attn_load(u32x4& kv, u32x4& vv, const bf16_t* base, int kcol, int vcol, int tid) {
    const unsigned loff = (unsigned)((tid >> 3) * 768 + 8 * (tid & 7)) * 2u;
    kv = *(const u32x4*)((const char*)(base + kcol) + loff);
    vv = *(const u32x4*)((const char*)(base + vcol) + loff);
}
__device__ __forceinline__ void attn_store(LAS unsigned char* KT, LAS unsigned char* VT, const u32x4& kv, const u32x4& vv, int tid) {
    const int key = tid >> 3, chk = tid & 7;
    *(LAS u32x4*)(KT + key * 144 + chk * 16) = kv;
    *(LAS u32x4*)(VT + key * 192 + chk * 16) = vv;
}

__device__ __forceinline__ int next_tile(unsigned& rem) { if (!rem) return -1; const int j = __builtin_ctz(rem); rem &= rem - 1u; return j; }
template <int MODE>
__device__ __forceinline__ void attn_pass(LAS unsigned char* lds, const bf16_t* KVb, int kcol, int vcol, unsigned rem, unsigned mysel, int qt, int s,
                                          const bf16x8 (&qf)[4], float& m, float& lsum, f32x16 (&O)[2], int tid, int lane) {
    u32x4 ak, av, bk, bv;
    int j = next_tile(rem), j1 = next_tile(rem), j2 = next_tile(rem);
    attn_load(ak, av, KVb + (size_t)(64 * j) * 768, kcol, vcol, tid);
    if (j1 >= 0) attn_load(bk, bv, KVb + (size_t)(64 * j1) * 768, kcol, vcol, tid);
    __syncthreads();
    attn_store(lds + AT_KT, lds + AT_VT, ak, av, tid);
    if (j2 >= 0) attn_load(ak, av, KVb + (size_t)(64 * j2) * 768, kcol, vcol, tid);
#define ATT_STEP(CB, NB, RK, RV) { \
        __syncthreads();                   \
        const int j3 = next_tile(rem); \
        if (j1 >= 0) { attn_store(lds + (NB), lds + (NB) + 9216, RK, RV, tid); if (j3 >= 0) attn_load(RK, RV, KVb + (size_t)(64 * j3) * 768, kcol, vcol, tid); } \
        if (MODE == 1) { const bool mine = (mysel >> j) & 1u; const unsigned long long bm = __ballot(mine); \
            if (bm != 0ull) attn_tile<1>(lds + (CB), lds + (CB) + 9216, qf, m, lsum, O, lane, s - 64 * j, mine, (bm != ~0ull) || (j == qt)); } \
        else attn_tile<2>(lds + (CB), lds + (CB) + 9216, qf, m, lsum, O, lane, s - 64 * j, true, (j == qt) || (j == qt - 8)); \
        if (j1 < 0) break; \
        j = j1; j1 = j2; j2 = j3; }
    for (;;) {
        ATT_STEP(AT_KT, AT_BUF2, bk, bv)
        ATT_STEP(AT_BUF2, AT_KT, ak, av)
    }
#undef ATT_STEP
}

__device__ __forceinline__ void attn_unit(CArgsP a, LAS unsigned char* lds, int b, int g, int qt, int tid, int wave, int lane) {
    LAS unsigned char* KT = lds + AT_KT; LAS unsigned char* VT = lds + AT_VT; LAS unsigned char* KCs = lds + AT_KC; LAS unsigned char* VCs = lds + AT_VC;
    LAS float* IMP4 = (LAS float*)(lds + AT_IMP4); LAS float* IMPF = (LAS float*)(lds + AT_IMPF); LAS unsigned* SELM = (LAS unsigned*)(lds + AT_SELM);
    const bf16_t* QR = (const bf16_t*)(a->ws + WS_QR); const bf16_t* KV = (const bf16_t*)(a->ws + WS_KV);
    const bf16_t* KCg = (const bf16_t*)(a->ws + WS_KC) + (size_t)(b * 2 + g) * 128 * 64; const bf16_t* VCg = (const bf16_t*)(a->ws + WS_VC) + (size_t)(b * 2 + g) * 128 * 64;
    const float* GATES = (const float*)(a->ws + WS_GATES); bf16_t* YA = (bf16_t*)(a->ws + WS_YA);
    const int hh = wave >> 1, qh = wave & 1, q = lane & 31, hi = lane >> 5, blk = (lane >> 4) & 1, qq = (lane & 15) >> 2, p = lane & 3;
    const int s = qt * 64 + qh * 32 + q, head = g * 4 + hh;
    const int row = b * 2048 + s;
#pragma unroll
    for (int i = 0; i < 2; ++i) {
        const int idx = tid + 512 * i, r = idx >> 3, c = idx & 7;
        *(LAS u32x4*)(KCs + r * 144 + c * 16) = *(const u32x4*)(KCg + r * 64 + c * 8);
        *(LAS u32x4*)(VCs + r * 192 + c * 16) = *(const u32x4*)(VCg + r * 64 + c * 8);
    }
    bf16x8 qf[4];
#pragma unroll
    for (int c = 0; c < 4; ++c) qf[c] = *(const bf16x8*)(QR + (size_t)row * 512 + head * 64 + 16 * c + 8 * hi);
    __syncthreads();
    f32x16 oacc[2];
    {
        f32x16 S[4];
#pragma unroll
        for (int kb = 0; kb < 4; ++kb) {
#pragma unroll
            for (int i = 0; i < 16; ++i) S[kb][i] = 0.f;
#pragma unroll
            for (int c = 0; c < 4; ++c) { const bf16x8 kf = *(const LAS bf16x8*)(KCs + (32 * kb + q) * 144 + (16 * c + 8 * hi) * 2); S[kb] = MFMA32(kf, qf[c], S[kb]); }
        }
        const int nlim = (s - 31) >> 4;
        float mx = -1e30f;
#pragma unroll
        for (int kb = 0; kb < 4; ++kb)
#pragma unroll
            for (int r = 0; r < 16; ++r) { const int n = 32 * kb + crow(r, hi); S[kb][r] = (n <= nlim) ? S[kb][r] : -1e30f; mx = fmaxf(mx, S[kb][r]); }
        mx = fmaxf(mx, __shfl_xor(mx, 32));
        float sum = 0.f;
#pragma unroll
        for (int kb = 0; kb < 4; ++kb)
#pragma unroll
            for (int r = 0; r < 16; ++r) { S[kb][r] = fexp2(S[kb][r] - mx); sum += S[kb][r]; }
        sum += __shfl_xor(sum, 32);
        const float inv = (s >= 31) ? 1.f / sum : 0.f;
        float prevX = 0.f;
        LAS float* impw = IMP4 + (hh * 64 + qh * 32 + q) * 33;
#pragma unroll
        for (int kb = 0; kb < 4; ++kb) {
#pragma unroll
            for (int r = 0; r < 16; ++r) S[kb][r] *= inv;
#pragma unroll
            for (int rr = 0; rr < 4; ++rr) {
                const float E = 0.5f * S[kb][4 * rr + 3];
                const float T = S[kb][4 * rr] + S[kb][4 * rr + 1] + S[kb][4 * rr + 2] + E;
                const float X = __shfl_xor(E, 32);
                impw[8 * kb + 2 * rr + hi] = T + (hi ? X : prevX);
                prevX = X;
            }
        }
        f32x16 O[2];
#pragma unroll
        for (int i = 0; i < 16; ++i) { O[0][i] = 0.f; O[1][i] = 0.f; }
#pragma unroll
        for (int kb = 0; kb < 4; ++kb)
#pragma unroll
            for (int sp = 0; sp < 2; ++sp) {
                const bf16x8 pf = PACK8(S[kb], sp);
#pragma unroll
                for (int dh = 0; dh < 2; ++dh) {
                    LAS unsigned char* vp = VCs + (32 * kb + 16 * sp + 4 * hi + qq) * 192 + (32 * dh + 16 * blk + 4 * p) * 2;
                    const bf16x8 vf = cat8(tr_read(vp), tr_read(vp + 8 * 192));
                    O[dh] = MFMA32(vf, pf, O[dh]);
                }
            }
        const float g0 = GATES[(size_t)row * 24 + head * 3 + 0];
#pragma unroll
        for (int i = 0; i < 16; ++i) { oacc[0][i] = g0 * O[0][i]; oacc[1][i] = g0 * O[1][i]; }
    }
    __syncthreads();
    {
        const int qi = tid >> 3, jb = tid & 7;
        float v[4];
#pragma unroll
        for (int jj = 0; jj < 4; ++jj) {
            const int j = 4 * jb + jj;
            float t = IMP4[(0 * 64 + qi) * 33 + j] + IMP4[(1 * 64 + qi) * 33 + j] + IMP4[(2 * 64 + qi) * 33 + j] + IMP4[(3 * 64 + qi) * 33 + j];
            const bool forced = (j == 0) || (j == qt) || (j == qt - 1), valid = j <= qt;
            t = forced ? 1e4f : (valid ? t : -1e4f);
            v[jj] = t; IMPF[qi * 33 + j] = t;
        }
        __syncthreads();
        unsigned bits = 0u;
#pragma unroll
        for (int jj = 0; jj < 4; ++jj) {
            const int j = 4 * jb + jj; int cnt = 0;
            for (int k = 0; k < 32; ++k) { const float w = IMPF[qi * 33 + k]; cnt += (w > v[jj] || (w == v[jj] && k < j)) ? 1 : 0; }
            bits |= (cnt < 16 ? 1u : 0u) << j;
        }
        bits |= __shfl_xor(bits, 1); bits |= __shfl_xor(bits, 2); bits |= __shfl_xor(bits, 4);
        if (jb == 0) SELM[qi] = bits;
        __syncthreads();
        if (tid < 64) {
            unsigned un = SELM[tid];
#pragma unroll
            for (int o = 1; o < 64; o <<= 1) un |= __shfl_xor(un, o);
            if (tid == 0) SELM[64] = un;
        }
        __syncthreads();
    }
    const unsigned mysel = SELM[qh * 32 + q], uni = SELM[64];
    const bf16_t* KVb = KV + (size_t)b * 2048 * 768;
    LAS float* stash = (LAS float*)(lds + AT_KC + wave * 8192) + lane;
#pragma unroll
    for (int i = 0; i < 16; ++i) { stash[i * 64] = oacc[0][i]; stash[(16 + i) * 64] = oacc[1][i]; }
    {
        float m = 0.f, lsum = 0.f; f32x16 O[2];
#pragma unroll
        for (int i = 0; i < 16; ++i) { O[0][i] = 0.f; O[1][i] = 0.f; }
        const unsigned rem = uni & (qt == 31 ? 0xffffffffu : ((2u << qt) - 1u));
        attn_pass<1>(lds, KVb, (4 + g) * 64, (6 + g) * 64, rem, mysel, qt, s, qf, m, lsum, O, tid, lane);
        const float sc = GATES[(size_t)row * 24 + head * 3 + 1] / lsum;
#pragma unroll
        for (int i = 0; i < 16; ++i) { stash[i * 64] += sc * O[0][i]; stash[(16 + i) * 64] += sc * O[1][i]; }
    }
    {
        float m = 0.f, lsum = 0.f; f32x16 O[2];
#pragma unroll
        for (int i = 0; i < 16; ++i) { O[0][i] = 0.f; O[1][i] = 0.f; }
        const unsigned all = (qt == 31 ? 0xffffffffu : ((2u << qt) - 1u)), lo = (qt > 8) ? ((1u << (qt - 8)) - 1u) : 0u;
        attn_pass<2>(lds, KVb, (8 + g) * 64, (10 + g) * 64, all & ~lo, 0u, qt, s, qf, m, lsum, O, tid, lane);
        const float sc = GATES[(size_t)row * 24 + head * 3 + 2] / lsum;
#pragma unroll
        for (int i = 0; i < 16; ++i) { oacc[0][i] = stash[i * 64] + sc * O[0][i]; oacc[1][i] = stash[(16 + i) * 64] + sc * O[1][i]; }
    }
#pragma unroll
    for (int dh = 0; dh < 2; ++dh)
#pragma unroll
        for (int rr = 0; rr < 4; ++rr) {
            u32x2 w; w.x = pk2(oacc[dh][4 * rr], oacc[dh][4 * rr + 1]); w.y = pk2(oacc[dh][4 * rr + 2], oacc[dh][4 * rr + 3]);
            *(u32x2*)(YA + (size_t)row * 512 + head * 64 + 32 * dh + 8 * rr + 4 * hi) = w;
        }
    __syncthreads();
}

struct PanelNormOrder : pg8::StaticOrder {
    unsigned* cnt; const unsigned* xtab; LAS unsigned char* lds; const float* h; float* fout; bf16_t* XN; const float* modp; const float* adab; const float* gvec; int l, i, fin, tid;
    __device__ __forceinline__ void done(const pg8::Unit& u) const {
        const int wave = __builtin_amdgcn_readfirstlane(tid >> 6), lane = tid & 63;
        LAS float* SH = (LAS float*)(lds + 131072 + 1024);
        asm volatile("s_waitcnt vmcnt(0)" ::: "memory");
        __syncthreads();
        if (tid == 0) {
            const unsigned* xt = xtab + u.pm * 4; const unsigned my = xb_xcc_id() + 1u;
            const bool same_l2 = (xt[0] == my) & (xt[1] == my) & (xt[2] == my) & (xt[3] == my);
            if (!same_l2) { __builtin_amdgcn_fence(__ATOMIC_RELEASE, "agent"); asm volatile("s_waitcnt vmcnt(0)" ::: "memory"); }
            unsigned* c = cnt + 16 * u.pm;
            __hip_atomic_fetch_add(c, 1u, __ATOMIC_RELAXED, __HIP_MEMORY_SCOPE_AGENT);
            unsigned sp = 0;
            while (__hip_atomic_load(c, __ATOMIC_RELAXED, __HIP_MEMORY_SCOPE_AGENT) < 4u) { __builtin_amdgcn_s_sleep(1); if (++sp > (1u << 22)) break; }
            __builtin_amdgcn_fence(__ATOMIC_ACQUIRE, "agent");
            asm volatile("s_waitcnt vmcnt(0)" ::: "memory");
        }
        __syncthreads();
        const int b = u.pm >> 3, r0 = u.pm * 256 + u.pn * 64;
        if (!fin) {
            const int which = tid >> 8, c4 = 4 * (tid & 255);
            f32x4 v = modv4(modp, adab, l, b, (i * 3 + which) * 1024 + c4);
            if (which) v += 1.f;
            *(LAS f32x4*)(SH + which * 1024 + c4) = v;
            __syncthreads();
        }
        for (int rb = 0; rb < 2; ++rb) {
            f32x4 v[4][4];
#pragma unroll
            for (int r4 = 0; r4 < 4; ++r4) {
                const f32x4* xr = (const f32x4*)(h + (size_t)(r0 + wave * 8 + rb * 4 + r4) * 1024) + lane;
#pragma unroll
                for (int j = 0; j < 4; ++j) v[r4][j] = xr[64 * j];
            }
#pragma unroll
            for (int r4 = 0; r4 < 4; ++r4) {
                const int row = r0 + wave * 8 + rb * 4 + r4;
                float ss = 0.f;
#pragma unroll
                for (int j = 0; j < 4; ++j) ss += (v[r4][j].x * v[r4][j].x + v[r4][j].y * v[r4][j].y) + (v[r4][j].z * v[r4][j].z + v[r4][j].w * v[r4][j].w);
                const float rstd = rsqrtf(wave_sum(ss) * (1.f / 1024.f) + 1e-6f);
#pragma unroll
                for (int j = 0; j < 4; ++j) {
                    const int col = 4 * lane + 256 * j;
                    const f32x4 g4 = *(const f32x4*)(gvec + col);
                    if (fin) { *((f32x4*)(fout + (size_t)row * 1024) + lane + 64 * j) = (v[r4][j] * rstd) * g4; }
                    else {
                        const f32x4 sh = *(const LAS f32x4*)(SH + col), sc = *(const LAS f32x4*)(SH + 1024 + col);
                        const f32x4 o = (v[r4][j] * rstd) * g4 * sc + sh;
                        u32x2 w; w.x = pk2(o.x, o.y); w.y = pk2(o.z, o.w);
                        *(u32x2*)(XN + (size_t)row * 1024 + col) = w;
                    }
                }
            }
        }
    }
};

#define XB_TMO      128
#define XB_XCNT(j)  (256  + 64 * (j))
#define XB_XSUB(j)  (1280 + 64 * (j))
#define XB_XGEN(j)  (2304 + 64 * (j))
#define XB_TOP      3328
#define XB_TOPGEN   3392
#define XCD_BAR_WORDS 3456
#define XB_SPIN_CAP (1u << 18)

__device__ __forceinline__ unsigned xb_ld(unsigned* p)              { return __hip_atomic_load(p, __ATOMIC_RELAXED, __HIP_MEMORY_SCOPE_AGENT); }
__device__ __forceinline__ unsigned xb_add(unsigned* p, unsigned v) { return __hip_atomic_fetch_add(p, v, __ATOMIC_RELAXED, __HIP_MEMORY_SCOPE_AGENT); }
__device__ __forceinline__ unsigned xb_xcc_id() { return (unsigned)__builtin_amdgcn_s_getreg((3 << 11) | 20) & 0xFu; }
#define XB_SPIN(cond, bar) do { unsigned _sp = 0; while (cond) { __builtin_amdgcn_s_sleep(1); \
    if ((++_sp & 255u) == 0u) { if (xb_ld(&(bar)[XB_TMO])) break; if (_sp > XB_SPIN_CAP) { atomicAdd(&(bar)[XB_TMO], 1u); break; } } } } while (0)

struct XcdBarrier {
    unsigned* bar; unsigned x;
    volatile LAS unsigned* st;
};

__device__ __forceinline__ XcdBarrier xcd_barrier_post(unsigned* bar, volatile LAS unsigned* st) {
    XcdBarrier b; b.bar = bar; b.x = xb_xcc_id(); b.st = st;
    if (threadIdx.x == 0) (void)xb_add(&bar[XB_XCNT(b.x)], 1u);
    return b;
}
__device__ __forceinline__ void xcd_barrier_complete(unsigned* bar, unsigned x, unsigned& nloc, unsigned& nx) {
    const unsigned G = gridDim.x * gridDim.y * gridDim.z;
    unsigned sum, cnt, mine, sp = 0u;
    for (;;) {
        sum = 0u; cnt = 0u; mine = 0u;
#pragma unroll
        for (unsigned j = 0; j < 16; ++j) { const unsigned c = xb_ld(&bar[XB_XCNT(j)]); sum += c; cnt += (c > 0u) ? 1u : 0u; mine = (j == x) ? c : mine; }
        if (sum == G) break;
        __builtin_amdgcn_s_sleep(1);
        if ((++sp & 255u) == 0u) { if (xb_ld(&bar[XB_TMO])) break; if (sp > XB_SPIN_CAP) { atomicAdd(&bar[XB_TMO], 1u); break; } }
    }
    nloc = mine > 0u ? mine : 1u; nx = cnt > 0u ? cnt : 1u;
}

__device__ __forceinline__ void xcd_barrier(const XcdBarrier& b) {
    asm volatile("s_waitcnt vmcnt(0)" ::: "memory");
    __syncthreads();
    if (threadIdx.x == 0) {
        unsigned* bar = b.bar;
        __builtin_amdgcn_s_waitcnt(0);
        unsigned nloc = b.st[0], nx = b.st[1];
        if (nloc == 0u) { xcd_barrier_complete(bar, b.x, nloc, nx); b.st[0] = nloc; b.st[1] = nx; }
        const unsigned old = xb_add(&bar[XB_XSUB(b.x)], 1u);
        const unsigned gen = old / nloc;
        if (old + 1u == (gen + 1u) * nloc) {
            __builtin_amdgcn_fence(__ATOMIC_RELEASE, "agent");
            asm volatile("s_waitcnt vmcnt(0)" ::: "memory");
            const unsigned og = xb_add(&bar[XB_TOP], 1u);
            const unsigned tg = og / nx;
            if (og + 1u == (tg + 1u) * nx) xb_add(&bar[XB_TOPGEN], 1u);
            else XB_SPIN(xb_ld(&bar[XB_TOPGEN]) == tg, bar);
            __builtin_amdgcn_fence(__ATOMIC_ACQUIRE, "agent");
            xb_add(&bar[XB_XGEN(b.x)], 1u);
            asm volatile("s_waitcnt vmcnt(0)" ::: "memory");
        } else {
            XB_SPIN(xb_ld(&bar[XB_XGEN(b.x)]) == gen, bar);
            __builtin_amdgcn_fence(__ATOMIC_ACQUIRE, "agent");
            asm volatile("s_waitcnt vmcnt(0)" ::: "memory");
        }
    }
    __syncthreads();
}

#define GRID_BAR() do { XcdBarrier xb_; xb_.bar = (unsigned*)(a->ws + WS_BAR); xb_.x = xb_xcc_id(); xb_.st = (volatile LAS unsigned*)(lds + 131072 + 256); xcd_barrier(xb_); } while (0)
template <int ph> __device__ __forceinline__ void phase_work(LAS unsigned char* lds, const int wave_in) {
        CArgsP a = (CArgsP)__builtin_amdgcn_kernarg_segment_ptr();
        int wave = wave_in, G = gridDim.x, bid = blockIdx.x;
        asm volatile("" : "+s"(a), "+s"(wave), "+s"(G), "+s"(bid));
        int lane = __builtin_amdgcn_mbcnt_hi(~0u, __builtin_amdgcn_mbcnt_lo(~0u, 0u));
        asm volatile("" : "+v"(lane));
        const int tid = wave * 64 + lane;
        if constexpr (ph == 0) { if (EN & 1) phase_prologue(a, lds, tid, wave, lane); }
        else if constexpr (ph == N_PHASES - 1) phase_final_norm(a, wave, lane);
        else {
            constexpr int l = (ph - 1) / 12, sub = (ph - 1) % 12;
            const float* hcur = (l == 0 && sub <= 2) ? a->in[0] : a->out;
            const float* modp = (const float*)(a->ws + WS_MODP); const float* adab = a->in[3];
            if constexpr ((EN & 2) && (sub == 0 || sub == 3 || sub == 9)) {
                phase_norm(a, lds, hcur, l, sub == 0 ? 0 : (sub == 3 ? 1 : 2), tid, wave, lane);
            } else if constexpr ((EN & 4) && (sub == 1 || sub == 10)) {
                const int w = l * 2 + (sub == 10 ? 1 : 0);
                pg8::Gemm gm{(const pg8::bf16_t*)(a->ws + WS_XN), (const pg8::bf16_t*)(a->ws + WS_WFI) + (size_t)w * NFF2 * 1024, MROWS, NFF2, 1024, 0, 1};
                pg8::StaticOrder S; S.init(MROWS, NFF2, G, bid);
                EpiSwiglu E{(bf16_t*)(a->ws + WS_HID)};
                pg8::gemm_phase<EpiSwiglu, pg8::StaticOrder, true, true>(lds, gm, S, E, tid);
                if constexpr (BG_PREP && l == 0) bg_prep(a, lds, (MROWS / 256) * (NFF2 / 256), sub == 1 ? 0 : 2, G, bid, tid, wave, lane);
            } else if constexpr ((EN & 8) && (sub == 2 || sub == 11)) {
                const int w = l * 2 + (sub == 11 ? 1 : 0);
                pg8::Gemm gm{(const pg8::bf16_t*)(a->ws + WS_HID), (const pg8::bf16_t*)(a->ws + WS_WFO) + (size_t)w * 1024 * DFF, MROWS, 1024, DFF, 1, 1};
                EpiResid E{hcur, a->out, modp, adab, l, (sub == 2 ? 2 : 8) * 1024, 0.5f};
                if constexpr (FUSE_NORM) {
                    const int fin = (sub == 11 && l == 1) ? 1 : 0, nl = (sub == 11) ? l + 1 : l, ni = (sub == 2) ? 1 : 0;
                    PanelNormOrder S; S.init(MROWS, 1024, G, bid);
                    S.cnt = (unsigned*)(a->ws + WS_CNT) + (l * 3 + (sub == 2 ? 0 : 2)) * 1024; S.xtab = (const unsigned*)(a->ws + WS_XT); S.lds = lds; S.h = a->out; S.fout = a->out; S.XN = (bf16_t*)(a->ws + WS_XN);
                    S.modp = modp; S.adab = adab; S.gvec = fin ? a->in[18] : a->in[4] + (nl * 3 + ni) * 1024; S.l = nl; S.i = ni; S.fin = fin; S.tid = tid;
                    pg8::gemm_phase<EpiResid, PanelNormOrder, true, true>(lds, gm, S, E, tid);
                } else {
                    pg8::StaticOrder S; S.init(MROWS, 1024, G, bid);
                    pg8::gemm_phase<EpiResid, pg8::StaticOrder, true, true>(lds, gm, S, E, tid);
                }
            } else if constexpr ((EN & 16) && sub == 4) {
                pg8::Gemm gm{(const pg8::bf16_t*)(a->ws + WS_XN), (const pg8::bf16_t*)(a->ws + WS_WMIX) + (size_t)l * NINP * 1024, MROWS, NINP, 1024, 0, 1};
                pg8::StaticOrder S; S.init(MROWS, NINP, G, bid);
                const float* rc = (const float*)(a->ws + WS_ROPE);
                EpiMix E{(bf16_t*)(a->ws + WS_QR), (bf16_t*)(a->ws + WS_KV), (bf16_t*)(a->ws + WS_EW), (float*)(a->ws + WS_GATES), rc, rc + 65536};
                pg8::gemm_phase<EpiMix, pg8::StaticOrder, true, true>(lds, gm, S, E, tid);
                if constexpr (BG_PREP && l == 0) bg_prep(a, lds, (MROWS / 256) * (NINP / 256), 1, G, bid, tid, wave, lane);
            } else if constexpr ((EN & 32) && sub == 5) {
                for (int u = bid; u < 512; u += G) {
                    if (u < 256) compress_unit(a, lds, l, u, tid, wave, lane);
                    else gmlp_unit(a, lds, l, u - 256, tid, wave, lane);
                }
            } else if constexpr ((EN & 64) && sub == 6) {
                for (int u = bid; u < 512; u += G) {
                    const int bg = u & 15, k = (u >> 4) & 15, qt = (u < 256) ? 31 - k : k;
                    attn_unit(a, lds, bg >> 1, bg & 1, qt, tid, wave, lane);
                }
            } else if constexpr ((EN & 128) && sub == 7) {
                pg8::StaticOrder S; S.init(MROWS, 1024, G, bid);
                { pg8::Gemm gm{(const pg8::bf16_t*)(a->ws + WS_YA), (const pg8::bf16_t*)(a->ws + WS_WPA) + (size_t)l * 1024 * 512, MROWS, 1024, 512, 0, 1};
                  EpiProj<0> E{(const bf16_t*)(a->ws + WS_EW), (bf16_t*)(a->ws + WS_MG)};
                  pg8::gemm_phase<EpiProj<0>, pg8::StaticOrder, true, true>(lds, gm, S, E, tid); }
                { pg8::Gemm gm{(const pg8::bf16_t*)(a->ws + WS_YB), (const pg8::bf16_t*)(a->ws + WS_WPB) + (size_t)l * 1024 * 512, MROWS, 1024, 512, 0, 1};
                  EpiProj<1> E{(const bf16_t*)(a->ws + WS_EW), (bf16_t*)(a->ws + WS_MG)};
                  pg8::gemm_phase<EpiProj<1>, pg8::StaticOrder, true, true>(lds, gm, S, E, tid); }
            } else if constexpr ((EN & 256) && sub == 8) {
                pg8::Gemm gm{(const pg8::bf16_t*)(a->ws + WS_MG), (const pg8::bf16_t*)(a->ws + WS_WO) + (size_t)l * 1024 * 1024, MROWS, 1024, 1024, 0, 1};
                EpiResid E{a->out, a->out, modp, adab, l, 5 * 1024, 1.0f};
                if constexpr (FUSE_NORM) {
                    PanelNormOrder S; S.init(MROWS, 1024, G, bid);
                    S.cnt = (unsigned*)(a->ws + WS_CNT) + (l * 3 + 1) * 1024; S.xtab = (const unsigned*)(a->ws + WS_XT); S.lds = lds; S.h = a->out; S.fout = a->out; S.XN = (bf16_t*)(a->ws + WS_XN);
                    S.modp = modp; S.adab = adab; S.gvec = a->in[4] + (l * 3 + 2) * 1024; S.l = l; S.i = 2; S.fin = 0; S.tid = tid;
                    pg8::gemm_phase<EpiResid, PanelNormOrder, true, true>(lds, gm, S, E, tid);
                } else {
                    pg8::StaticOrder S; S.init(MROWS, 1024, G, bid);
                    pg8::gemm_phase<EpiResid, pg8::StaticOrder, true, true>(lds, gm, S, E, tid);
                }
            }
        }
}
template <int ph> __device__ __forceinline__ void run_phase(LAS unsigned char* lds, cg::grid_group& grid, const int wave_in) {
    constexpr bool fused_away = FUSE_NORM && (ph == N_PHASES - 1 || (ph >= 1 && ((ph - 1) % 12 == 3 || (ph - 1) % 12 == 9 || ph == 13)));
    if constexpr (!fused_away) {
        CArgsP a = (CArgsP)__builtin_amdgcn_kernarg_segment_ptr();
        phase_work<ph>(lds, wave_in);
        constexpr bool again = (PROBE_REP && ph >= 1 && ph < N_PHASES - 1 && ((PROBE_REP >> ((ph - 1) % 12)) & 1)) || (ph == 0 && (PROBE_REP & 4096)) || (ph == 3 && (PROBE_REP & 8192));
        if constexpr (again) { GRID_BAR(); phase_work<ph>(lds, wave_in); }
        if constexpr (PROBE_SYNC >= 1) GRID_BAR();
        if constexpr (PROBE_SYNC >= 2) GRID_BAR();
        if constexpr (ph + 1 < N_PHASES - (FUSE_NORM ? 1 : 0)) { if constexpr (ph == 0) { if (a->ph_hi == 12345) grid.sync(); } GRID_BAR(); }
    }
}
__global__ void __launch_bounds__(NTHR, 2) fwd_kernel(Args a_by_value) {
    CArgsP a = (CArgsP)__builtin_amdgcn_kernarg_segment_ptr();
    extern __shared__ __attribute__((aligned(16))) unsigned char lds_raw[];
    LAS unsigned char* lds = (LAS unsigned char*)lds_raw;
    cg::grid_group grid = cg::this_grid();
    volatile LAS unsigned* bst = (volatile LAS unsigned*)(lds + 131072 + 256);
    if (threadIdx.x < 2) bst[threadIdx.x] = 0u;
    __syncthreads();
    (void)xcd_barrier_post((unsigned*)(a->ws + WS_BAR), bst);
    const int wv = __builtin_amdgcn_readfirstlane(threadIdx.x >> 6);
    run_phase<0>(lds, grid, wv); run_phase<1>(lds, grid, wv); run_phase<2>(lds, grid, wv); run_phase<3>(lds, grid, wv); run_phase<4>(lds, grid, wv); run_phase<5>(lds, grid, wv); run_phase<6>(lds, grid, wv);
    run_phase<7>(lds, grid, wv); run_phase<8>(lds, grid, wv); run_phase<9>(lds, grid, wv); run_phase<10>(lds, grid, wv); run_phase<11>(lds, grid, wv); run_phase<12>(lds, grid, wv); run_phase<13>(lds, grid, wv);
    run_phase<14>(lds, grid, wv); run_phase<15>(lds, grid, wv); run_phase<16>(lds, grid, wv); run_phase<17>(lds, grid, wv); run_phase<18>(lds, grid, wv); run_phase<19>(lds, grid, wv); run_phase<20>(lds, grid, wv);
    run_phase<21>(lds, grid, wv); run_phase<22>(lds, grid, wv); run_phase<23>(lds, grid, wv); run_phase<24>(lds, grid, wv); run_phase<25>(lds, grid, wv);
}

extern "C" void kernel_launch(void* const* d_in, const int* in_sizes, int n_in, void* d_out, int out_size, void* d_ws, size_t ws_size, hipStream_t stream) {
    static int grid = 0;
    if (grid == 0) {
        if (n_in != 19 || out_size != MROWS * DM || ws_size < WS_END) { fprintf(stderr, "kernel_launch: unexpected shapes (n_in %d out %d ws %zu)\n", n_in, out_size, ws_size); grid = -1; return; }
        int dev = 0, cus = 0, per_cu = 0;
        hipGetDevice(&dev);
        hipDeviceGetAttribute(&cus, hipDeviceAttributeMultiprocessorCount, dev);
        if (hipFuncSetAttribute((const void*)fwd_kernel, hipFuncAttributeMaxDynamicSharedMemorySize, LDS_BYTES) != hipSuccess) { fprintf(stderr, "kernel_launch: hipFuncSetAttribute failed\n"); grid = -1; return; }
        if (hipOccupancyMaxActiveBlocksPerMultiprocessor(&per_cu, (const void*)fwd_kernel, NTHR, LDS_BYTES) != hipSuccess || per_cu < 1) { fprintf(stderr, "kernel_launch: occupancy query gave %d\n", per_cu); per_cu = 1; }
        (void)hipGetLastError();
        grid = cus * 1;
        if (grid > 256) grid = 256;
    }
    if (grid < 0) return;
    if (hipMemsetAsync((char*)d_ws + WS_BAR, 0, 16384 + 6 * 1024 * 4, stream) != hipSuccess) { fprintf(stderr, "kernel_launch: memset failed\n"); return; }
    Args a{};
    for (int i = 0; i < 19; ++i) a.in[i] = (const float*)d_in[i];
    a.out = (float*)d_out; a.ws = (unsigned char*)d_ws; a.ph_lo = 0; a.ph_hi = N_PHASES;
    void* args[] = {&a};
    hipError_t e = hipLaunchCooperativeKernel((const void*)fwd_kernel, dim3(grid), dim3(NTHR), args, LDS_BYTES, stream);
    if (e != hipSuccess) fprintf(stderr, "cooperative launch failed: %s (grid %d)\n", hipGetErrorString(e), grid);
}
```
